# Optimizing an MI355X kernel written in HIP

```python
import math
import jax, jax.numpy as jnp
from jax import lax
import numpy as np

D_MODEL = 1024
BATCH = 16
SEQ = 2048
DEPTH = 1

CHUNK = 64
N_META = 16
D_MIX = D_MODEL
D_A = D_MIX // 2
HEAD_A = 64
H_A = D_A // HEAD_A
LORA_W = 64
LORA_A = 64
LORA_G = 128
DECAY_SCALE = math.exp(-0.5)
GN_EPS_A = 64e-5
D_B = D_MIX - D_A
H_B = 4
HEAD_B = D_B // H_B
ROPE_BASE = 10000.0
GN_EPS_B = 1e-5
P_A = 3 * D_A + LORA_W + LORA_A + LORA_G
P_B = 4 * D_B
P_IN = P_A + P_B
N_GROUPS = 4
EXPERTS_PER_GROUP = 8
N_EXPERTS = N_GROUPS * EXPERTS_PER_GROUP
TOP_K = 2
D_EXPERT = 512
MOE_BLOCK = 128
NORM_EPS = 1e-6

kernel_name = 'hybrid_rwkv7_retention_hmoe'


def rmsnorm(x, g):
    xf = x.astype(jnp.float32)
    y = xf * lax.rsqrt(jnp.mean(xf * xf, axis=-1, keepdims=True) + NORM_EPS)
    return (y * g.astype(jnp.float32)).astype(x.dtype)


def head_norm(y, eps):
    mean = jnp.mean(y, axis=-1, keepdims=True)
    var = jnp.mean(jnp.square(y - mean), axis=-1, keepdims=True)
    return (y - mean) * lax.rsqrt(var + eps)


def rwkv7_mix(z, mu, decay_w0, decay_up, iclr_a0, iclr_up, gate_up, k_k, k_a, r_k, ln_w, ln_b):
    zf = z.astype(jnp.float32)
    z_prev = jnp.pad(zf, ((0, 0), (1, 0), (0, 0)))[:, :-1]
    zs = zf + (z_prev - zf) * mu
    offs = [D_A, 2 * D_A, 3 * D_A, 3 * D_A + LORA_W, 3 * D_A + LORA_W + LORA_A]
    r, k, v, w_lo, a_lo, g_lo = jnp.split(zs, offs, axis=-1)
    log_w = -DECAY_SCALE * jax.nn.sigmoid(decay_w0 + jnp.tanh(w_lo) @ decay_up)
    a = jax.nn.sigmoid(iclr_a0 + a_lo @ iclr_up)
    g = jax.nn.sigmoid(g_lo) @ gate_up
    B_, L_, _ = r.shape
    hs = lambda t: t.reshape(B_, L_, H_A, HEAD_A)
    r, k, v, a, log_w = hs(r), hs(k), hs(v), hs(a), hs(log_w)
    kk = k * k_k.reshape(H_A, HEAD_A)
    kk = kk / jnp.maximum(jnp.sqrt(jnp.sum(kk * kk, axis=-1, keepdims=True)), 1e-12)
    k = k * (1.0 + (a - 1.0) * k_a.reshape(H_A, HEAD_A))
    w = jnp.exp(log_w)

    def step(S, inp):
        r_t, w_t, k_t, v_t, kk_t, b_t = inp
        S = (S * w_t[:, :, None, :]
             + jnp.einsum('bhvk,bhk->bhv', S, -kk_t)[..., None] * b_t[:, :, None, :]
             + v_t[..., None] * k_t[:, :, None, :])
        return S, jnp.einsum('bhvk,bhk->bhv', S, r_t)

    xs = tuple(jnp.moveaxis(t, 1, 0) for t in (r, w, k, v, kk, kk * a))
    S0 = jnp.zeros((B_, H_A, HEAD_A, HEAD_A), jnp.float32)
    _, y = lax.scan(step, S0, xs)
    y = jnp.moveaxis(y, 0, 1)
    y = head_norm(y, GN_EPS_A).reshape(B_, L_, D_A) * ln_w + ln_b
    bonus = jnp.sum(r * k * r_k.reshape(H_A, HEAD_A), axis=-1, keepdims=True) * v
    return (y + bonus.reshape(B_, L_, D_A)) * g


def retention_mix(z, gn_w):
    zf = z.astype(jnp.float32)
    q, k, v, g = jnp.split(zf, 4, axis=-1)
    B_, L_, _ = q.shape
    q = q.reshape(B_, L_, H_B, HEAD_B)
    k = k.reshape(B_, L_, H_B, HEAD_B)
    v = v.reshape(B_, L_, H_B, HEAD_B)
    pos = jnp.arange(L_, dtype=jnp.float32)
    inv_freq = ROPE_BASE ** (-jnp.arange(0, HEAD_B, 2, dtype=jnp.float32) / HEAD_B)
    ang = pos[:, None] * inv_freq[None, :]
    cos = jnp.cos(ang)[None, :, None, :]
    sin = jnp.sin(ang)[None, :, None, :]

    def rope(t):
        t1, t2 = jnp.split(t, 2, axis=-1)
        return jnp.concatenate([t1 * cos - t2 * sin, t1 * sin + t2 * cos], axis=-1)

    q = rope(q)
    k = rope(k) * (HEAD_B ** -0.5)
    pad = (-L_) % CHUNK
    n_chunks = (L_ + pad) // CHUNK

    def chunked(t):
        t = jnp.pad(t, ((0, 0), (pad, 0), (0, 0), (0, 0)))
        return t.reshape(B_, n_chunks, CHUNK, H_B, HEAD_B).transpose(1, 0, 3, 2, 4)

    qc, kc, vc = chunked(q), chunked(k), chunked(v)
    log_gamma = jnp.log1p(-jnp.exp2(-5.0 - jnp.arange(H_B, dtype=jnp.float32)))
    idx = jnp.arange(CHUNK)
    rel = idx[:, None] - idx[None, :]
    decay_in = jnp.where(rel >= 0, jnp.exp(log_gamma[:, None, None] * jnp.maximum(rel, 0).astype(jnp.float32)), 0.0)
    q_decay = jnp.exp(log_gamma[:, None] * (idx + 1).astype(jnp.float32))
    k_decay = jnp.exp(log_gamma[:, None] * (CHUNK - 1 - idx).astype(jnp.float32))
    chunk_decay = jnp.exp(log_gamma * CHUNK)
    scores = jnp.einsum('nbhcd,nbhmd->nbhcm', qc, kc) * decay_in
    inner = jnp.einsum('nbhcm,nbhme->nbhce', scores, vc)

    def step(R, inp):
        q_c, k_c, v_c = inp
        cross = jnp.einsum('bhcd,bhde->bhce', q_c, R) * q_decay[None, :, :, None]
        R = R * chunk_decay[None, :, None, None] + jnp.einsum('bhmd,bhme->bhde', k_c * k_decay[None, :, :, None], v_c)
        return R, cross

    R0 = jnp.zeros((B_, H_B, HEAD_B, HEAD_B), jnp.float32)
    _, cross = lax.scan(step, R0, (qc, kc, vc))
    y = (inner + cross).transpose(1, 0, 3, 2, 4).reshape(B_, n_chunks * CHUNK, H_B, HEAD_B)[:, pad:]
    y = head_norm(y, GN_EPS_B).reshape(B_, L_, D_B) * gn_w
    return y * jax.nn.silu(g)


def hier_moe(u, w_rg, b_rg, w_re, b_re, w_gate, w_up, w_down):
    B_, L_, D_ = u.shape
    T = B_ * L_
    uf = u.reshape(T, D_)
    group_prob = jax.nn.softmax((uf @ w_rg).astype(jnp.float32) + b_rg.astype(jnp.float32), axis=-1)
    g_p, g_idx = lax.top_k(group_prob, 1)
    exp_logits = ((uf @ w_re).astype(jnp.float32) + b_re.astype(jnp.float32)).reshape(T, N_GROUPS, EXPERTS_PER_GROUP)
    exp_logits = exp_logits[jnp.arange(T), g_idx[:, 0]]
    e_p, e_idx = lax.top_k(jax.nn.softmax(exp_logits, axis=-1), TOP_K)
    weight = g_p * e_p / jnp.sum(e_p, axis=-1, keepdims=True)
    expert = g_idx * EXPERTS_PER_GROUP + e_idx
    n_assign = T * TOP_K
    e_flat = expert.reshape(-1).astype(jnp.int32)
    w_flat = weight.reshape(-1)
    tok_flat = jnp.repeat(jnp.arange(T, dtype=jnp.int32), TOP_K)
    order = jnp.argsort(e_flat)
    e_s, w_s, tok_s = e_flat[order], w_flat[order], tok_flat[order]
    counts = jnp.zeros((N_EXPERTS,), jnp.int32).at[e_flat].add(1)
    padded = (counts + MOE_BLOCK - 1) // MOE_BLOCK * MOE_BLOCK
    pad_end = jnp.cumsum(padded)
    pad_start = pad_end - padded
    raw_start = jnp.cumsum(counts) - counts
    dest = pad_start[e_s] + jnp.arange(n_assign, dtype=jnp.int32) - raw_start[e_s]
    n_blocks = -(-(n_assign + N_EXPERTS * (MOE_BLOCK - 1)) // MOE_BLOCK)
    n_rows = n_blocks * MOE_BLOCK
    row_tok = jnp.zeros((n_rows,), jnp.int32).at[dest].set(tok_s)
    row_w = jnp.zeros((n_rows,), jnp.float32).at[dest].set(w_s)
    block_expert = jnp.minimum(jnp.searchsorted(pad_end, jnp.arange(n_blocks, dtype=jnp.int32) * MOE_BLOCK, side='right'), N_EXPERTS - 1)
    x_rows = uf[row_tok].reshape(n_blocks, MOE_BLOCK, D_)

    def run_block(args):
        xb, e = args
        hid = jax.nn.silu(xb @ w_gate[e]) * (xb @ w_up[e])
        return hid @ w_down[e]

    y_rows = lax.map(run_block, (x_rows, block_expert)).reshape(n_rows, D_)
    out = jnp.zeros((T, D_), u.dtype).at[row_tok].add(y_rows * row_w[:, None].astype(u.dtype))
    return out.reshape(B_, L_, D_)


def setup_inputs(seed: int = 0) -> dict:
    key = jax.random.key(seed)
    ks = iter(jax.random.split(key, 32))
    f32 = jnp.float32
    nrm = lambda shape, scale: jax.random.normal(next(ks), shape, f32) * scale
    D = D_MODEL
    return {
        'x': nrm((BATCH, SEQ, D), 1.0),
        'meta_tokens': nrm((N_META, D), 1.0),
        'norm_mix': 1.0 + nrm((DEPTH, D), 0.02),
        'w_in': nrm((DEPTH, D, P_IN), D ** -0.5),
        'shift_mu': jax.random.uniform(next(ks), (DEPTH, P_A), f32, 0.1, 0.9),
        'decay_w0': jax.random.uniform(next(ks), (DEPTH, D_A), f32, -3.0, 3.0),
        'decay_up': nrm((DEPTH, LORA_W, D_A), 0.5 * LORA_W ** -0.5),
        'iclr_a0': nrm((DEPTH, D_A), 0.5),
        'iclr_up': nrm((DEPTH, LORA_A, D_A), 0.5 * LORA_A ** -0.5),
        'gate_up': nrm((DEPTH, LORA_G, D_A), LORA_G ** -0.5),
        'k_k': 0.85 + nrm((DEPTH, D_A), 0.05),
        'k_a': 1.0 + nrm((DEPTH, D_A), 0.05),
        'r_k': nrm((DEPTH, D_A), 0.1),
        'ln_w_a': 1.0 + nrm((DEPTH, D_A), 0.02),
        'ln_b_a': nrm((DEPTH, D_A), 0.02),
        'gn_w_b': 1.0 + nrm((DEPTH, D_B), 0.02),
        'w_out': nrm((DEPTH, D_MIX, D), D_MIX ** -0.5),
        'norm_ffn': 1.0 + nrm((DEPTH, D), 0.02),
        'router_group_w': nrm((DEPTH, D, N_GROUPS), D ** -0.5),
        'router_group_b': nrm((DEPTH, N_GROUPS), 0.01),
        'router_expert_w': nrm((DEPTH, D, N_EXPERTS), D ** -0.5),
        'router_expert_b': nrm((DEPTH, N_EXPERTS), 0.01),
        'moe_w_gate': nrm((DEPTH, N_EXPERTS, D, D_EXPERT), D ** -0.5),
        'moe_w_up': nrm((DEPTH, N_EXPERTS, D, D_EXPERT), D ** -0.5),
        'moe_w_down': nrm((DEPTH, N_EXPERTS, D_EXPERT, D), D_EXPERT ** -0.5),
        'norm_final': 1.0 + nrm((D,), 0.02),
    }


def reference(x, meta_tokens, norm_mix, w_in, shift_mu, decay_w0, decay_up, iclr_a0, iclr_up, gate_up,
              k_k, k_a, r_k, ln_w_a, ln_b_a, gn_w_b, w_out, norm_ffn, router_group_w, router_group_b,
              router_expert_w, router_expert_b, moe_w_gate, moe_w_up, moe_w_down, norm_final):
    B_ = x.shape[0]
    meta = jnp.broadcast_to(meta_tokens[None].astype(x.dtype), (B_, N_META, x.shape[-1]))
    h = jnp.concatenate([meta, x], axis=1)
    for i in range(DEPTH):
        u = rmsnorm(h, norm_mix[i])
        z = u @ w_in[i]
        y_a = rwkv7_mix(z[..., :P_A], shift_mu[i], decay_w0[i], decay_up[i], iclr_a0[i], iclr_up[i], gate_up[i],
                        k_k[i], k_a[i], r_k[i], ln_w_a[i], ln_b_a[i])
        y_b = retention_mix(z[..., P_A:], gn_w_b[i])
        mixed = jnp.concatenate([y_a, y_b], axis=-1).astype(h.dtype)
        h = h + mixed @ w_out[i]
        u = rmsnorm(h, norm_ffn[i])
        h = h + hier_moe(u, router_group_w[i], router_group_b[i], router_expert_w[i], router_expert_b[i],
                         moe_w_gate[i], moe_w_up[i], moe_w_down[i])
    return rmsnorm(h, norm_final)[:, N_META:]
```

```cpp
#include <hip/hip_runtime.h>
#include <cstdio>
#include <cstdint>

#define LAS __attribute__((address_space(3)))
#define GAS __attribute__((address_space(1)))
typedef unsigned short bf16_t;
typedef short bf16x8 __attribute__((ext_vector_type(8)));
typedef float f32x4 __attribute__((ext_vector_type(4)));
typedef unsigned u32x4 __attribute__((ext_vector_type(4)));
typedef unsigned u32x2 __attribute__((ext_vector_type(2)));

constexpr int D = 1024, NBATCH = 16, SEQ = 2048, NMETA = 16, L = SEQ + NMETA, M1 = NBATCH * L, M2 = NBATCH * SEQ;
constexpr int PA = 1792, PB = 2048, PIN = PA + PB;
constexpr int NE = 32, DE = 512, NASG = 2 * M2, NROWS_PAD = 73728;
constexpr int GI = 128;
constexpr int NPHASE = 11;

constexpr size_t MiB = 1u << 20, KiB = 1u << 10;
constexpr size_t WS_CTL = 0, CTL_ZERO_BYTES = 65536;
constexpr size_t WS_WIN = 1 * MiB;
constexpr size_t WS_WOUT = 9 * MiB;
constexpr size_t WS_LORA = 11 * MiB;
constexpr size_t WS_WR = 11 * MiB + 512 * KiB;
constexpr size_t WS_ROPE = 12 * MiB;
constexpr size_t ROPE_HALF = (size_t)L * 64 * 4;
constexpr size_t WS_RSTD1 = 13 * MiB + 256 * KiB;
constexpr size_t WS_SLOT0 = 14 * MiB + 320 * KiB;
constexpr size_t WS_ZMETA = 13 * MiB + 400 * KiB;
constexpr size_t WS_CH = 13 * MiB + 512 * KiB;
constexpr size_t RT_ROWW = 13 * MiB + 512 * KiB, RT_ROWRS = 14 * MiB;
constexpr size_t WS_ROUTE = 14 * MiB + 768 * KiB;
constexpr size_t RT_E = WS_ROUTE, RT_W = WS_ROUTE + 256 * KiB, RT_POS = WS_ROUTE + 512 * KiB, RT_ROW = WS_ROUTE + 768 * KiB,
                 RT_RSTD2 = WS_ROUTE + 1088 * KiB, RT_CNT = WS_ROUTE + 1216 * KiB, RT_TOT = WS_ROUTE + 1248 * KiB;
constexpr size_t WS_ZA = 16 * MiB;
constexpr size_t WS_ZB = 130 * MiB;
constexpr size_t WS_HB = 260 * MiB;
constexpr size_t PS = (size_t)M1 * 512 * 2;
constexpr size_t WS_P = 326 * MiB;
constexpr size_t WS_PR = WS_HB, WS_PK = WS_HB + PS, WS_PW = WS_P, WS_PKK = WS_P + PS, WS_PB = WS_P + 2 * PS, WS_PV = WS_P + 3 * PS, WS_PG = WS_P + 4 * PS;
constexpr size_t WS_Y = 16 * MiB;
constexpr size_t WS_YB = 81 * MiB;
constexpr size_t WS_MIXED = WS_P;
constexpr size_t WS_HMID = WS_ZB;
constexpr size_t WS_WGU = 16 * MiB;
constexpr size_t WS_WD = 80 * MiB;
constexpr size_t WS_U2 = WS_HMID;
constexpr size_t WS_U8 = WS_HB;
constexpr size_t WS_HID = 392 * MiB;
constexpr size_t WS_YM0 = WS_HB, WS_YM1 = WS_P;
constexpr int NCHUNK = 65, SLOT_BYTES = 22528, SL_G = 0, SL_KT = 8192, SL_WQ = 12288, SL_AQK = 16384, SL_V = 18432;
constexpr size_t WS_SLOT = 260 * MiB;
constexpr size_t WS_G2 = 440 * MiB, WS_CV = 473 * MiB;
constexpr size_t WS_END = 506 * MiB;
static_assert(WS_SLOT + (size_t)NBATCH * 8 * NCHUNK * SLOT_BYTES <= WS_G2 && WS_G2 + PS <= WS_CV && WS_CV + PS <= WS_END, "ws map rwkv");
static_assert(WS_ZA + (size_t)M1 * PA * 2 <= WS_ZB && WS_ZB + (size_t)M1 * PB * 2 <= WS_HB && WS_HB + 2 * PS <= WS_P && WS_P + 5 * PS <= WS_END, "ws map");
static_assert(WS_Y + (size_t)M1 * 512 * 4 <= WS_YB && WS_YB + PS <= WS_ZA + (size_t)M1 * PA * 2, "ws map y");
static_assert(WS_MIXED + (size_t)M2 * 1024 * 2 <= WS_PB && WS_HID >= WS_PB && WS_HID + (size_t)NROWS_PAD * 512 * 2 <= WS_END, "ws map 2");
static_assert(WS_WD + (size_t)32 * 1024 * 512 * 2 <= WS_ZA + (size_t)M1 * PA * 2, "ws map 3");

constexpr int CW_BAR = 1024;
constexpr int LDS_BYTES = 163840, LDS_XB = LDS_BYTES - 64;

__device__ __forceinline__ unsigned f2bf(float f) { unsigned u = __builtin_bit_cast(unsigned, f); return (u + 0x7fffu + ((u >> 16) & 1u)) >> 16; }
typedef float f32x2_t __attribute__((ext_vector_type(2)));
typedef __bf16 bf16x2_t __attribute__((ext_vector_type(2)));
__device__ __forceinline__ unsigned pk2(float lo, float hi) { f32x2_t v = {lo, hi}; bf16x2_t b = __builtin_convertvector(v, bf16x2_t); return __builtin_bit_cast(unsigned, b); }
__device__ __forceinline__ unsigned pk4_fp8(float a, float b, float c, float d) { int w = 0; w = __builtin_amdgcn_cvt_pk_fp8_f32(a, b, w, false); w = __builtin_amdgcn_cvt_pk_fp8_f32(c, d, w, true); return (unsigned)w; }
__device__ __forceinline__ float bflo(unsigned w) { return __builtin_bit_cast(float, w << 16); }
__device__ __forceinline__ float bfhi(unsigned w) { return __builtin_bit_cast(float, w & 0xffff0000u); }
__device__ __forceinline__ float bf2f(bf16_t b) { return __builtin_bit_cast(float, (unsigned)b << 16); }
__device__ __forceinline__ float sigmoidf_(float x) { return __builtin_amdgcn_rcpf(1.f + __builtin_amdgcn_exp2f(-1.4426950408889634f * x)); }
__device__ __forceinline__ float tanhf_(float x) { return 2.f * sigmoidf_(2.f * x) - 1.f; }
__device__ __forceinline__ float wave_sum(float v) {
#pragma unroll
    for (int o = 1; o < 64; o <<= 1) v += __shfl_xor(v, o);
    return v;
}
__device__ __forceinline__ float row16_sum(float v) {
    v += __builtin_bit_cast(float, __builtin_amdgcn_update_dpp(0, __builtin_bit_cast(int, v), 0xB1, 0xF, 0xF, false));
    v += __builtin_bit_cast(float, __builtin_amdgcn_update_dpp(0, __builtin_bit_cast(int, v), 0x4E, 0xF, 0xF, false));
    v += __builtin_bit_cast(float, __builtin_amdgcn_update_dpp(0, __builtin_bit_cast(int, v), 0x141, 0xF, 0xF, false));
    v += __builtin_bit_cast(float, __builtin_amdgcn_update_dpp(0, __builtin_bit_cast(int, v), 0x140, 0xF, 0xF, false));
    return v;
}
#define LDS_WAIT() asm volatile("s_waitcnt lgkmcnt(0)" ::: "memory")
#define VM_WAIT() asm volatile("s_waitcnt vmcnt(0)" ::: "memory")

#define XB_TMO      128
#define XB_XCNT(j)  (256  + 64 * (j))
#define XB_XSUB(j)  (1280 + 64 * (j))
#define XB_XGEN(j)  (2304 + 64 * (j))
#define XB_TOP      3328
#define XB_TOPGEN   3392
#define XCD_BAR_WORDS 3456
#define XB_SPIN_CAP (1u << 18)
__device__ __forceinline__ unsigned xb_ld(unsigned* p)              { return __hip_atomic_load(p, __ATOMIC_RELAXED, __HIP_MEMORY_SCOPE_AGENT); }
__device__ __forceinline__ unsigned xb_add(unsigned* p, unsigned v) { return __hip_atomic_fetch_add(p, v, __ATOMIC_RELAXED, __HIP_MEMORY_SCOPE_AGENT); }
__device__ __forceinline__ unsigned xb_xcc_id() { return (unsigned)__builtin_amdgcn_s_getreg((3 << 11) | 20) & 0xFu; }
#define XB_SPIN(cond, bar) do { unsigned _sp = 0; while (cond) { __builtin_amdgcn_s_sleep(1); \
    if ((++_sp & 255u) == 0u) { if (xb_ld(&(bar)[XB_TMO])) break; if (_sp > XB_SPIN_CAP) { atomicAdd(&(bar)[XB_TMO], 1u); break; } } } } while (0)
struct XcdBarrier { unsigned* bar; unsigned x; volatile LAS unsigned* st; };
__device__ __forceinline__ XcdBarrier xcd_barrier_post(unsigned* bar, volatile LAS unsigned* st) {
    XcdBarrier b; b.bar = bar; b.x = xb_xcc_id(); b.st = st;
    if (threadIdx.x == 0) (void)xb_add(&bar[XB_XCNT(b.x)], 1u);
    return b;
}
__device__ __forceinline__ void xcd_barrier_complete(unsigned* bar, unsigned x, unsigned& nloc, unsigned& nx) {
    const unsigned G = gridDim.x * gridDim.y * gridDim.z;
    unsigned sum, cnt, mine, sp = 0u;
    for (;;) {
        sum = 0u; cnt = 0u; mine = 0u;
#pragma unroll
        for (unsigned j = 0; j < 16; ++j) { const unsigned c = xb_ld(&bar[XB_XCNT(j)]); sum += c; cnt += (c > 0u) ? 1u : 0u; mine = (j == x) ? c : mine; }
        if (sum == G) break;
        __builtin_amdgcn_s_sleep(1);
        if ((++sp & 255u) == 0u) { if (xb_ld(&bar[XB_TMO])) break; if (sp > XB_SPIN_CAP) { atomicAdd(&bar[XB_TMO], 1u); break; } }
    }
    nloc = mine > 0u ? mine : 1u; nx = cnt > 0u ? cnt : 1u;
}
__device__ __forceinline__ void xcd_barrier(const XcdBarrier& b) {
    asm volatile("s_waitcnt vmcnt(0)" ::: "memory");
    __syncthreads();
    if (threadIdx.x == 0) {
        unsigned* bar = b.bar;
        __builtin_amdgcn_s_waitcnt(0);
        unsigned nloc = b.st[0], nx = b.st[1];
        if (nloc == 0u) { xcd_barrier_complete(bar, b.x, nloc, nx); b.st[0] = nloc; b.st[1] = nx; }
        const unsigned old = xb_add(&bar[XB_XSUB(b.x)], 1u);
        const unsigned gen = old / nloc;
        if (old + 1u == (gen + 1u) * nloc) {
            __builtin_amdgcn_fence(__ATOMIC_RELEASE, "agent");
            asm volatile("s_waitcnt vmcnt(0)" ::: "memory");
            const unsigned og = xb_add(&bar[XB_TOP], 1u);
            const unsigned tg = og / nx;
            if (og + 1u == (tg + 1u) * nx) xb_add(&bar[XB_TOPGEN], 1u);
            else XB_SPIN(xb_ld(&bar[XB_TOPGEN]) == tg, bar);
            __builtin_amdgcn_fence(__ATOMIC_ACQUIRE, "agent");
            xb_add(&bar[XB_XGEN(b.x)], 1u);
            asm volatile("s_waitcnt vmcnt(0)" ::: "memory");
        } else {
            XB_SPIN(xb_ld(&bar[XB_XGEN(b.x)]) == gen, bar);
            __builtin_amdgcn_fence(__ATOMIC_ACQUIRE, "agent");
            asm volatile("s_waitcnt vmcnt(0)" ::: "memory");
        }
    }
    __syncthreads();
}

struct Params { const float* in[26]; float* out; unsigned char* ws; int ph_lo, ph_hi; };

namespace pg8 {
typedef int v8i_t __attribute__((ext_vector_type(8)));
typedef short bf16x16_t __attribute__((ext_vector_type(16)));
constexpr int BM = 256, BK = 64, HALF = 128, HTB = HALF * BK * 2, STAGE_BYTES = 8 * HTB, NXCD = 8, WGM = 8;
__host__ __device__ __forceinline__ int lds_byte(int r, int c) { const int st = (r >> 4) * 2 + (c >> 5), rr = r & 15, cc = c & 31, ob = rr * 64 + cc * 2; return st * 1024 + (ob ^ (((ob >> 9) & 1) << 5)); }
__host__ __device__ __forceinline__ void stage_rc(int b, int& R, int& C) { const int st = b / 1024, sb = b % 1024, swz = sb ^ (((sb >> 9) & 1) << 5); R = (st >> 1) * 16 + swz / 64; C = (st & 1) * 32 + (swz % 64) / 2; }
__host__ __device__ __forceinline__ int perm32(int rho) { const int n = rho >> 4, i = rho & 15; return 8 * (i >> 2) + 4 * n + (i & 3); }

struct DenseOrder {
    static constexpr bool GATHER = false, FP8 = false;
    struct Unit { int pm, pn; };
    const bf16_t* A; const bf16_t* Bt; int K; int nM, nN, nwg, G, c;
    __device__ __forceinline__ void init(const bf16_t* A_, const bf16_t* Bt_, int M, int N, int K_, int G_, int c_) { A = A_; Bt = Bt_; K = K_; nM = M / BM; nN = N / BM; nwg = nM * nN; G = G_; c = c_; }
    __device__ __forceinline__ bool next(int i, Unit& u) const {
        const long Lx = (long)i * G + c; if (Lx >= nwg) return false;
        int wgid = (int)Lx; { const int q = nwg / NXCD, r = nwg % NXCD, xcd = wgid % NXCD, off = wgid / NXCD; wgid = (xcd < r ? xcd * (q + 1) : r * (q + 1) + (xcd - r) * q) + off; }
        const int nig = WGM * nN, gid = wgid / nig, fm = gid * WGM, gsz = (nM - fm) < WGM ? (nM - fm) : WGM;
        u.pm = fm + ((wgid % nig) % gsz); u.pn = (wgid % nig) / gsz; return true;
    }
    __device__ __forceinline__ const char* a_base(const Unit& u) const { return (const char*)A + (size_t)u.pm * BM * K * 2; }
    __device__ __forceinline__ const char* b_base(const Unit& u) const { return (const char*)Bt + (size_t)u.pn * BM * K * 2; }
    __device__ __forceinline__ void a_tok(const Unit&, int, unsigned& w0, unsigned& w1) const { w0 = 0u; w1 = 0u; }
};

template <class Epi, class Sched, bool ALIGN_EPI>
__device__ __forceinline__ void gemm_phase(LAS unsigned char* lds, const Sched& S, const Epi& E) {
    constexpr bool GATHER = Sched::GATHER, FP8 = Sched::FP8;
    int tid = threadIdx.x; asm volatile("" : "+v"(tid));
    const int wid = __builtin_amdgcn_readfirstlane(tid >> 6), lane = tid & 63, wr = wid >> 2, wc = wid & 3, fr = lane & 15, fq = lane >> 4;
    const int K = S.K, KB = FP8 ? K : 2 * K, nt = KB / 128;
    unsigned voffB[2], vA[2];
    LAS u32x4* slot = (LAS u32x4*)(lds + 132096) + tid;
#pragma unroll
    for (int i = 0; i < 2; ++i) { int R, C; stage_rc(tid * 16 + i * 8192, R, C); const int Rb = Epi::PERM ? ((R & ~31) + perm32(R & 31)) : R; voffB[i] = (unsigned)(Rb * KB + C * 2);
                                  vA[i] = GATHER ? (unsigned)C * 2u : (unsigned)(R * KB + C * 2); }
    const size_t kstep = (size_t)(BK * 2);
    const size_t hstep = (size_t)HALF * KB;
    const size_t hsA = GATHER ? (size_t)0 : hstep;
    const unsigned rowB = (unsigned)KB;
    const unsigned ldsw = (unsigned)wid * 1024u;
    const int aoff = FP8 ? lds_byte(wr * 64 + fr, fq * 16) : lds_byte(wr * 64 + fr, fq * 8), boff = FP8 ? lds_byte(wc * 32 + fr, fq * 16) : lds_byte(wc * 32 + fr, fq * 8);
    const int one_scale = 0x7F7F7F7F;
    constexpr int KOFS = FP8 ? 16 : 1024;
#define PG8_SA(b, h) (((b) * 2 + (h)) * HTB)
#define PG8_SB(b, h) ((4 + (b) * 2 + (h)) * HTB)
#define PG8_STAGE(bufoff, gbase, voff) do { _Pragma("unroll") for (int _i = 0; _i < 2; ++_i) \
        __builtin_amdgcn_global_load_lds((const unsigned*)((const char*)(gbase) + (voff)[_i]), (LAS unsigned*)(lds + (bufoff) + ldsw + _i * 8192), 16, 0, 0); } while (0)
#define PG8_OFFS(dst, word) do { if (GATHER) { dst[0] = ((word) & 0xffffu) * rowB + vA[0]; dst[1] = ((word) >> 16) * rowB + vA[1]; } else { dst[0] = vA[0]; dst[1] = vA[1]; } } while (0)
#define PG8_LDA(dst, b, h) do { _Pragma("unroll") for (int m = 0; m < 4; ++m) _Pragma("unroll") for (int k = 0; k < 2; ++k) dst[m][k] = *(const LAS bf16x8*)(lds + PG8_SA(b, h) + aoff + m * 2048 + k * KOFS); } while (0)
#define PG8_LDB(dst, b, h) do { _Pragma("unroll") for (int n = 0; n < 2; ++n) _Pragma("unroll") for (int k = 0; k < 2; ++k) dst[n][k] = *(const LAS bf16x8*)(lds + PG8_SB(b, h) + boff + n * 2048 + k * KOFS); } while (0)
#define PG8_MMA(ai, bj, At, Bt) do { __builtin_amdgcn_s_setprio(1); _Pragma("unroll") for (int m = 0; m < 4; ++m) _Pragma("unroll") for (int n = 0; n < 2; ++n) { \
        if constexpr (FP8) { const u32x4 b0_ = __builtin_bit_cast(u32x4, Bt[n][0]), b1_ = __builtin_bit_cast(u32x4, Bt[n][1]), a0_ = __builtin_bit_cast(u32x4, At[m][0]), a1_ = __builtin_bit_cast(u32x4, At[m][1]); \
            const v8i_t bv_ = (v8i_t){(int)b0_.x, (int)b0_.y, (int)b0_.z, (int)b0_.w, (int)b1_.x, (int)b1_.y, (int)b1_.z, (int)b1_.w}, av_ = (v8i_t){(int)a0_.x, (int)a0_.y, (int)a0_.z, (int)a0_.w, (int)a1_.x, (int)a1_.y, (int)a1_.z, (int)a1_.w}; \
            asm volatile("v_mfma_scale_f32_16x16x128_f8f6f4 %0, %1, %2, %0, %3, %3 op_sel_hi:[0,0,0]" : "+v"(acc[ai][bj][m][n]) : "v"(bv_), "v"(av_), "v"(one_scale)); }   \
        else { _Pragma("unroll") for (int k = 0; k < 2; ++k) acc[ai][bj][m][n] = __builtin_amdgcn_mfma_f32_16x16x32_bf16(Bt[n][k], At[m][k], acc[ai][bj][m][n], 0, 0, 0); } } __builtin_amdgcn_s_setprio(0); } while (0)
#define PG8_WAIT_V(n) asm volatile("s_waitcnt vmcnt(" #n ")" ::: "memory")
#define PG8_WAIT_L(n) asm volatile("s_waitcnt lgkmcnt(" #n ")" ::: "memory")
#define PG8_BAR __builtin_amdgcn_s_barrier()
#define PG8_SCHED __builtin_amdgcn_sched_barrier(0)
    typename Sched::Unit cur, nxt; int ui = 0;
    if (!S.next(0, cur)) return;
    f32x4 acc[2][2][4][2];
#pragma unroll
    for (int a = 0; a < 2; ++a)
#pragma unroll
        for (int b = 0; b < 2; ++b)
#pragma unroll
            for (int m = 0; m < 4; ++m)
#pragma unroll
                for (int n = 0; n < 2; ++n) acc[a][b][m][n] = (f32x4){0.f, 0.f, 0.f, 0.f};
    bf16x8 At[4][2], B0[2][2], B1[2][2];
    const char* cA = S.a_base(cur); const char* cB = S.b_base(cur);
    {
        unsigned w0 = 0u, w1 = 0u, o0[2], o1[2];
        if (GATHER) { S.a_tok(cur, tid, w0, w1); *slot = (u32x4){w0, w1, w0, w1}; }
        PG8_OFFS(o0, w0); PG8_OFFS(o1, w1);
        PG8_STAGE(PG8_SB(0, 0), cB, voffB); PG8_STAGE(PG8_SB(0, 1), cB + hstep, voffB); PG8_STAGE(PG8_SA(0, 0), cA, o0); PG8_STAGE(PG8_SA(0, 1), cA + hsA, o1);
        if (wr == 1) PG8_BAR;
        PG8_WAIT_V(2); PG8_BAR;
        PG8_STAGE(PG8_SB(1, 0), cB + kstep, voffB); PG8_STAGE(PG8_SA(1, 0), cA + kstep, o0); PG8_STAGE(PG8_SB(1, 1), cB + hstep + kstep, voffB);
        PG8_WAIT_V(6); PG8_BAR;
    }
    for (;;) {
        const bool has_next = S.next(ui + 1, nxt);
        const char* nA = has_next ? S.a_base(nxt) : cA; const char* nB = has_next ? S.b_base(nxt) : cB;
        if (GATHER && has_next) { unsigned w0, w1; S.a_tok(nxt, tid, w0, w1); const u32x4 t4 = *slot; *slot = (u32x4){t4.x, t4.y, w0, w1}; }
        for (int t = 0; t < nt; t += 2) {
            const bool last = (t == nt - 2);
            const char* a1 = cA + (size_t)(t + 1) * kstep;
            const char* a2 = last ? nA : cA + (size_t)(t + 2) * kstep; const char* b2 = last ? nB : cB + (size_t)(t + 2) * kstep;
            const char* a3 = a2 + kstep; const char* b3 = b2 + kstep;
            unsigned c1[2], x0[2], x1[2];
            if (GATHER) { const u32x4 t4 = *slot; PG8_OFFS(c1, t4.y); const unsigned wx0 = last ? t4.z : t4.x, wx1 = last ? t4.w : t4.y; PG8_OFFS(x0, wx0); PG8_OFFS(x1, wx1); }
            else { PG8_OFFS(c1, 0u); PG8_OFFS(x0, 0u); PG8_OFFS(x1, 0u); }
            PG8_LDB(B0, 0, 0); PG8_LDB(B1, 0, 1); PG8_SCHED; PG8_LDA(At, 0, 0); PG8_STAGE(PG8_SA(1, 1), a1 + hsA, c1);
            PG8_WAIT_V(8); PG8_WAIT_L(0); PG8_BAR; PG8_MMA(0, 0, At, B0); PG8_MMA(0, 1, At, B1); PG8_BAR; PG8_SCHED;
            PG8_LDA(At, 0, 1); PG8_STAGE(PG8_SB(0, 0), b2, voffB); PG8_STAGE(PG8_SB(0, 1), b2 + hstep, voffB); PG8_STAGE(PG8_SA(0, 0), a2, x0);
            PG8_WAIT_V(8); PG8_WAIT_L(0); PG8_BAR; PG8_MMA(1, 0, At, B0); PG8_MMA(1, 1, At, B1); PG8_BAR; PG8_SCHED;
            PG8_LDB(B0, 1, 0); PG8_LDB(B1, 1, 1); PG8_SCHED; PG8_LDA(At, 1, 0); PG8_STAGE(PG8_SA(0, 1), a2 + hsA, x1);
            PG8_WAIT_V(8); PG8_WAIT_L(0); PG8_BAR; PG8_MMA(0, 0, At, B0); PG8_MMA(0, 1, At, B1); PG8_BAR; PG8_SCHED;
            PG8_LDA(At, 1, 1); PG8_STAGE(PG8_SB(1, 0), b3, voffB); PG8_STAGE(PG8_SB(1, 1), b3 + hstep, voffB); PG8_STAGE(PG8_SA(1, 0), a3, x0);
            PG8_WAIT_V(8); PG8_WAIT_L(0); PG8_BAR; PG8_MMA(1, 0, At, B0); PG8_MMA(1, 1, At, B1); PG8_BAR; PG8_SCHED;
        }
        if constexpr (ALIGN_EPI) { if (wr == 0) PG8_BAR; }
        {
            int tz = tid; asm volatile("" : "+v"(tz)); const int lz = tz & 63, wz = __builtin_amdgcn_readfirstlane(tz >> 6);
            if constexpr (FP8) asm volatile("s_nop 15\n\ts_nop 15" ::: "memory");
            E(acc, cur, wz >> 2, wz & 3, lz & 15, lz >> 4);
        }
        if (!has_next) break;
#pragma unroll
        for (int a = 0; a < 2; ++a)
#pragma unroll
            for (int b = 0; b < 2; ++b)
#pragma unroll
                for (int m = 0; m < 4; ++m)
#pragma unroll
                    for (int n = 0; n < 2; ++n) acc[a][b][m][n] = (f32x4){0.f, 0.f, 0.f, 0.f};
        cur = nxt; cA = nA; cB = nB; ++ui;
        if (GATHER) { const u32x4 t4 = *slot; *slot = (u32x4){t4.z, t4.w, t4.z, t4.w}; }
        if constexpr (ALIGN_EPI) { if (wr == 1) PG8_BAR; }
    }
    PG8_WAIT_V(0);
    if constexpr (!ALIGN_EPI) { if (wr == 0) PG8_BAR; }
    PG8_BAR;
#undef PG8_SA
#undef PG8_SB
#undef PG8_STAGE
#undef PG8_OFFS
#undef PG8_LDA
#undef PG8_LDB
#undef PG8_MMA
#undef PG8_WAIT_V
#undef PG8_WAIT_L
#undef PG8_BAR
#undef PG8_SCHED
}
}


__device__ __forceinline__ void tr_load(const float* W, int N, int item, int lane, f32x4 (&v)[16]) {
    const int nblk = N / 64, kb = item / nblk, nb = item % nblk, k0 = 64 * kb, n0 = 64 * nb;
    const int col4 = (lane & 15) * 4, r4 = lane >> 4;
#pragma unroll
    for (int i = 0; i < 16; ++i) v[i] = *(const f32x4*)(W + (size_t)(k0 + 4 * i + r4) * N + n0 + col4);
}
template <bool PERMK = false, bool F8 = false, class RowMap>
__device__ __forceinline__ void tr_store(f32x4 (&v)[16], int K, int N, bf16_t* WT, const RowMap& rmap, const float* kscale, LAS float* scr, int item, int lane) {
    const int nblk = N / 64, kb = item / nblk, nb = item % nblk, k0 = 64 * kb, n0 = 64 * nb;
    const int col4 = (lane & 15) * 4, r4 = lane >> 4;
#pragma unroll
    for (int i = 0; i < 16; ++i) {
        const int kk = 4 * i + r4;
        if (kscale) v[i] = v[i] * kscale[k0 + kk];
        *(LAS f32x4*)(scr + kk * 64 + (col4 ^ (4 * (kk >> 3)))) = v[i];
    }
    LDS_WAIT(); asm volatile("" ::: "memory");
    const int c = lane & 7;
#pragma unroll
    for (int j = 0; j < 8; ++j) {
        const int n = (lane >> 3) + 8 * j; const LAS float* s = scr + (8 * c) * 64 + (n ^ (4 * c));
        u32x4 o;
        if (PERMK) {
            float f[8];
#pragma unroll
            for (int e = 0; e < 8; ++e) { const int kk = 16 * ((2 * c + (e >> 2)) & 3) + 4 * (c >> 1) + (e & 3); f[e] = scr[kk * 64 + (n ^ (4 * (kk >> 3)))]; }
            o.x = pk2(f[0], f[1]); o.y = pk2(f[2], f[3]); o.z = pk2(f[4], f[5]); o.w = pk2(f[6], f[7]);
        } else if (F8) { *(u32x2*)((unsigned char*)WT + (size_t)rmap(n0 + n) * K + k0 + 8 * c) = (u32x2){pk4_fp8(32.f * s[0 * 64], 32.f * s[1 * 64], 32.f * s[2 * 64], 32.f * s[3 * 64]), pk4_fp8(32.f * s[4 * 64], 32.f * s[5 * 64], 32.f * s[6 * 64], 32.f * s[7 * 64])}; continue;
        } else { o.x = pk2(s[0 * 64], s[1 * 64]); o.y = pk2(s[2 * 64], s[3 * 64]); o.z = pk2(s[4 * 64], s[5 * 64]); o.w = pk2(s[6 * 64], s[7 * 64]); }
        *(u32x4*)(WT + (size_t)rmap(n0 + n) * K + k0 + 8 * c) = o;
    }
    LDS_WAIT(); asm volatile("" ::: "memory");
}
template <bool PERMK = false, class RowMap>
__device__ __forceinline__ void transpose_item(const float* W, int K, int N, bf16_t* WT, const RowMap& rmap, const float* kscale, LAS float* scr, int item, int lane) {
    f32x4 v[16];
    tr_load(W, N, item, lane, v);
    tr_store<PERMK>(v, K, N, WT, rmap, kscale, scr, item, lane);
}
struct MapId { __device__ __forceinline__ int operator()(int n) const { return n; } };
struct MapZ { __device__ __forceinline__ int operator()(int n) const { if (n < PA || n >= PA + 1024) return n; const int o = (n - PA) & 127; return n - o + 2 * (o & 63) + (o >> 6); } };
struct MapGU { int up; __device__ __forceinline__ int operator()(int n) const { return 2 * GI * (n / GI) + GI * up + (n % GI); } };

__device__ __forceinline__ void phase0(const Params& p, LAS unsigned char* lds, int tid, int lane, int wid, int G, int bid) {
    LAS float* scr = (LAS float*)(lds + wid * 16384);
    const int gw = bid * 8 + wid, NGW = G * 8;
    unsigned char* ws = p.ws;
    constexpr int I_IN = 16 * 60, I_OUT = 16 * 16, I_DEC = 8, I_ICL = 8, I_GATE = 16, NIT = I_IN + I_OUT + I_DEC + I_ICL + I_GATE;
    MapId id;
    for (int it = gw; it < NIT; it += NGW) {
        int r = it;
        if (r < I_IN) { MapZ mz; transpose_item(p.in[3], 1024, PIN, (bf16_t*)(ws + WS_WIN), mz, p.in[2], scr, r, lane); continue; } r -= I_IN;
        if (r < I_OUT) { if (r < I_OUT / 2) transpose_item<true>(p.in[16], 1024, 1024, (bf16_t*)(ws + WS_WOUT), id, nullptr, scr, r, lane);
                         else transpose_item(p.in[16], 1024, 1024, (bf16_t*)(ws + WS_WOUT), id, nullptr, scr, r, lane); continue; } r -= I_OUT;
        if (r < I_DEC) { transpose_item(p.in[6], 64, 512, (bf16_t*)(ws + WS_LORA), id, nullptr, scr, r, lane); continue; } r -= I_DEC;
        if (r < I_ICL) { transpose_item(p.in[8], 64, 512, (bf16_t*)(ws + WS_LORA + 64 * KiB), id, nullptr, scr, r, lane); continue; } r -= I_ICL;
        transpose_item(p.in[9], 128, 512, (bf16_t*)(ws + WS_LORA + 128 * KiB), id, nullptr, scr, r, lane);
    }
    {
        bf16_t* Wr = (bf16_t*)(ws + WS_WR); const float* gf = p.in[17]; const float* wrg = p.in[18]; const float* wre = p.in[20];
        for (int i = bid * 512 + tid; i < 36 * 1024; i += G * 512) {
            const int j = i >> 10, k = i & 1023;
            const float v = (j < 4) ? gf[k] * wrg[k * 4 + j] : gf[k] * wre[k * 32 + (j - 4)];
            const unsigned hi = f2bf(v); const float r = v - __builtin_bit_cast(float, hi << 16);
            Wr[i] = (bf16_t)hi; Wr[36 * 1024 + i] = (bf16_t)f2bf(r);
        }
    }
    {
        float* rc = (float*)(ws + WS_ROPE); float* rs = (float*)(ws + WS_ROPE + ROPE_HALF);
        for (int i = bid * 512 + tid; i < L * 64; i += G * 512) {
            const int pos = i >> 6, j = i & 63;
            const double inv = pow(10000.0, -(double)(2 * j) / 128.0); const double ang = (double)pos * inv;
            rc[i] = (float)cos(ang); rs[i] = (float)sin(ang);
        }
    }
    if (bid < 28) {
        LAS float* mg = (LAS float*)lds; LAS float* red = mg + 16 * 1024; LAS float* rsm = red + 8 * 16 * 64;
        const float* meta = p.in[1]; const float* nm = p.in[2]; const float* win = p.in[3];
        __syncthreads();
        for (int i = tid; i < 16 * 1024; i += 512) mg[i] = meta[i] * nm[i & 1023];
        for (int r = 2 * wid; r < 2 * wid + 2; ++r) { float ss = 0.f; for (int k = lane; k < 1024; k += 64) { const float v = meta[r * 1024 + k]; ss += v * v; } ss = wave_sum(ss); if (lane == 0) rsm[r] = 1.f / sqrtf(ss * (1.f / D) + 1e-6f); }
        __syncthreads();
        const int col = bid * 64 + (tid & 63), ksl = tid >> 6;
        float accm[16];
#pragma unroll
        for (int t = 0; t < 16; ++t) accm[t] = 0.f;
        for (int k = 128 * ksl; k < 128 * ksl + 128; ++k) {
            const float w = win[(size_t)k * PIN + col];
#pragma unroll
            for (int t = 0; t < 16; ++t) accm[t] += mg[t * 1024 + k] * w;
        }
#pragma unroll
        for (int t = 0; t < 16; ++t) red[(ksl * 16 + t) * 64 + (tid & 63)] = accm[t];
        __syncthreads();
        for (int o = tid; o < 16 * 64; o += 512) {
            const int t = o >> 6, cc = o & 63; float v = 0.f;
#pragma unroll
            for (int q = 0; q < 8; ++q) v += red[(q * 16 + t) * 64 + cc];
            ((bf16_t*)(ws + WS_ZMETA))[t * PA + bid * 64 + cc] = (bf16_t)f2bf(v * rsm[t]);
        }
        __syncthreads();
    }
    {
        bf16_t* hb = (bf16_t*)(ws + WS_HB); float* rstd = (float*)(ws + WS_RSTD1); const float* x = p.in[0]; const float* meta = p.in[1];
        for (int m = gw; m < M1; m += NGW) {
            const int b = m / L, t = m - b * L;
            const float* src = (t < NMETA) ? meta + (size_t)t * D : x + ((size_t)b * SEQ + (t - NMETA)) * D;
            f32x4 v[4]; float s = 0.f;
#pragma unroll
            for (int j = 0; j < 4; ++j) { v[j] = *(const f32x4*)(src + 4 * lane + 256 * j); s += (v[j].x * v[j].x + v[j].y * v[j].y) + (v[j].z * v[j].z + v[j].w * v[j].w); }
            s = wave_sum(s);
            if (lane == 0) rstd[m] = 1.f / sqrtf(s * (1.f / D) + 1e-6f);
#pragma unroll
            for (int j = 0; j < 4; ++j) { u32x2 o; o.x = pk2(v[j].x, v[j].y); o.y = pk2(v[j].z, v[j].w); *(u32x2*)(hb + (size_t)m * D + 4 * lane + 256 * j) = o; }
        }
    }
}

__device__ __forceinline__ float ret_lg2(int h) { return (h == 0) ? -0.04580368961312479f : (h == 1) ? -0.02272007650008353f : (h == 2) ? -0.011315313227834146f : -0.005646563141142063f; }
struct EpiZ2 {
    static constexpr bool PERM = true;
    bf16_t* zA; bf16_t* zB; const float* rstd; const float* ropeC; const float* ropeS;
    __device__ __forceinline__ void operator()(const f32x4 (&acc)[2][2][4][2], const pg8::DenseOrder::Unit& u, int wr, int wc, int fr, int fq) const {
        const int row0 = u.pm * 256 + wr * 64 + fr;
        bf16_t* base = (u.pn < 7) ? zA : zB; const int ld = (u.pn < 7) ? PA : PB; const int colt = (u.pn < 7) ? u.pn * 256 : (u.pn - 7) * 256;
        const int col0 = colt + wc * 32 + 8 * fq;
        const bool rot = (u.pn >= 7) && (u.pn < 11), isq = u.pn < 9;
        const int hd0 = 2 * (u.pn - (isq ? 7 : 9));
#pragma unroll
        for (int ai = 0; ai < 2; ++ai)
#pragma unroll
            for (int m = 0; m < 4; ++m) {
                const int row = row0 + ai * 128 + m * 16; const float rs = rstd[row];
                bf16_t* rowp = base + (size_t)row * ld + col0;
                if (rot) {
                    const int t = row - (row / L) * L; const float ic = (float)((t + 48) & 63);
                    const f32x4 c4 = *(const f32x4*)(ropeC + (size_t)t * 64 + 16 * wc + 4 * fq), s4 = *(const f32x4*)(ropeS + (size_t)t * 64 + 16 * wc + 4 * fq);
#pragma unroll
                    for (int bj = 0; bj < 2; ++bj) {
                        const float e = ic * ret_lg2(hd0 + bj), f = isq ? rs * __builtin_amdgcn_exp2f(e) : rs * 0.08838834764831845f * __builtin_amdgcn_exp2f(-e);
                        float o[8];
#pragma unroll
                        for (int n = 0; n < 2; ++n)
#pragma unroll
                            for (int h2 = 0; h2 < 2; ++h2) {
                                const float t1 = acc[ai][bj][m][n][2 * h2], t2 = acc[ai][bj][m][n][2 * h2 + 1], cc = c4[2 * n + h2], sn = s4[2 * n + h2];
                                o[4 * n + 2 * h2] = (t1 * cc - t2 * sn) * f; o[4 * n + 2 * h2 + 1] = (t1 * sn + t2 * cc) * f;
                            }
                        *(u32x4*)(rowp + bj * 128) = (u32x4){pk2(o[0], o[1]), pk2(o[2], o[3]), pk2(o[4], o[5]), pk2(o[6], o[7])};
                    }
                } else {
#pragma unroll
                    for (int bj = 0; bj < 2; ++bj) {
                        const f32x4 v0 = acc[ai][bj][m][0] * rs, v1 = acc[ai][bj][m][1] * rs;
                        *(u32x4*)(rowp + bj * 128) = (u32x4){pk2(v0[0], v0[1]), pk2(v0[2], v0[3]), pk2(v1[0], v1[1]), pk2(v1[2], v1[3])};
                    }
                }
            }
    }
};
__device__ __forceinline__ void phase1(const Params& p, LAS unsigned char* lds, int tid, int G, int bid) {
    unsigned char* ws = p.ws;
    pg8::DenseOrder S; S.init((const bf16_t*)(ws + WS_HB), (const bf16_t*)(ws + WS_WIN), M1, PIN, D, G, bid);
    EpiZ2 E{(bf16_t*)(ws + WS_ZA), (bf16_t*)(ws + WS_ZB), (const float*)(ws + WS_RSTD1), (const float*)(ws + WS_ROPE), (const float*)(ws + WS_ROPE + ROPE_HALF)};
    pg8::gemm_phase<EpiZ2, pg8::DenseOrder, true>(lds, S, E);
}

#ifndef PROBE_REP
#define PROBE_REP -1
#endif
#define SUBREP(k) int nsub_##k = ((PROBE_REP == (k)) ? 2 : 1); if (PROBE_REP == (k)) asm volatile("" : "+s"(nsub_##k)); for (int sr_ = 0; sr_ < nsub_##k; ++sr_)
typedef short v4i16_t __attribute__((ext_vector_type(4)));
__device__ __forceinline__ bf16x8 tr8(const LAS unsigned char* p0, const LAS unsigned char* p1) {
    const v4i16_t a = __builtin_amdgcn_ds_read_tr16_b64_v4i16((LAS v4i16_t*)p0), b = __builtin_amdgcn_ds_read_tr16_b64_v4i16((LAS v4i16_t*)p1);
    return (bf16x8){a[0], a[1], a[2], a[3], b[0], b[1], b[2], b[3]};
}
__device__ __forceinline__ bf16x8 packf(const f32x4& a, const f32x4& b) { return __builtin_bit_cast(bf16x8, (u32x4){pk2(a[0], a[1]), pk2(a[2], a[3]), pk2(b[0], b[1]), pk2(b[2], b[3])}); }
#define DPP_SHR(x, n) __builtin_bit_cast(float, __builtin_amdgcn_update_dpp(0, __builtin_bit_cast(int, (x)), 0x110 + (n), 0xF, 0xF, true))
#define MF(a, b, c) __builtin_amdgcn_mfma_f32_16x16x32_bf16((a), (b), (c), 0, 0, 0)
template <bool META>
__device__ __forceinline__ void phase_rwkv_pre(const Params& p, LAS unsigned char* lds, int tid, int lane, int wid, int G, int bid) {
    unsigned char* ws = p.ws;
    const bf16_t* zA = META ? (const bf16_t*)(ws + WS_ZMETA) : (const bf16_t*)(ws + WS_ZA);
    const float* mu = p.in[4]; const float* w0 = p.in[5]; const float* a0 = p.in[7]; const float* kkp = p.in[10]; const float* kap = p.in[11]; const float* rkp = p.in[12];
    const bf16_t* decT = (const bf16_t*)(ws + WS_LORA); const bf16_t* iclT = (const bf16_t*)(ws + WS_LORA + 64 * KiB); const bf16_t* gatT = (const bf16_t*)(ws + WS_LORA + 128 * KiB);
    bf16_t* Pg = (bf16_t*)(ws + WS_G2); bf16_t* Pcv = (bf16_t*)(ws + WS_CV);
    LAS unsigned char* scr = lds + wid * 18176;
    LAS unsigned char* Al = scr; LAS unsigned char* Bl = scr + 4608; LAS unsigned char* Kl = scr + 9216;
    LAS float* Tm = (LAS float*)(scr + 13824);
    LAS float* gC = (LAS float*)(scr + 17920);
    LAS float* PRM = (LAS float*)(lds + 145408);
    LAS float* MUL = PRM + 8 * 512;
    __syncthreads();
    for (int i = tid; i < 8 * 512; i += 512) { const int q = i >> 9, c = i & 511;
        PRM[i] = (q == 0) ? mu[c] : (q == 1) ? mu[512 + c] : (q == 2) ? mu[1024 + c] : (q == 3) ? w0[c] : (q == 4) ? a0[c] : (q == 5) ? kkp[c] : (q == 6) ? kap[c] : rkp[c]; }
    if (tid < 256) MUL[tid] = mu[1536 + tid];
    __syncthreads();
    for (int unit = META ? 0 : bid; unit < (META ? 1 : NBATCH * (NCHUNK - 1)); unit += G) {
        const int b = META ? 0 : unit >> 6, c = META ? 0 : (unit & 63) + 1, t0 = 32 * c - 16;
        int lz = lane, h = wid; asm volatile("" : "+v"(lz), "+s"(h));
        const int fr = lz & 15, fq = lz >> 4;
        float z0_ = 0.f; asm volatile("" : "+v"(z0_)); const f32x4 Z4 = (f32x4){z0_, z0_, z0_, z0_}; const unsigned zu_ = __builtin_bit_cast(unsigned, z0_); const u32x4 ZU4 = (u32x4){zu_, zu_, zu_, zu_};
        u32x4 cur[2][3][2];
#define CURLOAD(MT) do { const int t_ = t0 + (MT) * 16 + fr; const bf16_t* zc_ = zA + ((size_t)b * L + (t_ >= 0 ? t_ : 0)) * PA + h * 64 + 16 * fq; \
            _Pragma("unroll") for (int q_ = 0; q_ < 3; ++q_) { cur[MT][q_][0] = ZU4; cur[MT][q_][1] = ZU4; if (t_ >= 0) { cur[MT][q_][0] = *(const u32x4*)(zc_ + 512 * q_); cur[MT][q_][1] = *(const u32x4*)(zc_ + 512 * q_ + 8); } } } while (0)
        CURLOAD(0);
        LAS unsigned char* bndl = (LAS unsigned char*)Tm + 256;
        LAS unsigned char* bndlo = bndl + 384;
        if (t0 > 0) { if (lz < 56) __builtin_amdgcn_global_load_lds((const unsigned*)((lz < 24) ? zA + ((size_t)b * L + t0 - 1) * PA + h * 64 + 512 * (lz >> 3) + 8 * (lz & 7) : zA + ((size_t)b * L + t0 - 1) * PA + 1536 + 8 * (lz - 24)), (LAS unsigned*)bndl, 16, 0, 0); }
        else if (lz < 56) *(LAS u32x4*)(bndl + lz * 16) = ZU4;
        if (t0 + 15 >= 0) { if (lz < 32) __builtin_amdgcn_global_load_lds((const unsigned*)(zA + ((size_t)b * L + t0 + 15) * PA + 1536 + 8 * lz), (LAS unsigned*)(bndl + 1024), 16, 0, 0); }
        else if (lz < 32) *(LAS u32x4*)(bndl + 1024 + lz * 16) = ZU4;
        const int wrow = h * 64 + 16 * (fr >> 2) + (fr & 3);
        unsigned char* slotb = META ? ws + WS_SLOT0 + (size_t)h * SLOT_BYTES : ws + WS_SLOT + ((size_t)(b * 8 + h) * NCHUNK + c) * SLOT_BYTES;
        u32x2 R2[2][4];
        u32x4 lc[8];
#define LOC(f) (((f) < 4) ? 128 + (f) * 32 + fq * 8 : ((f) < 6) ? ((f) - 4) * 32 + fq * 8 : 64 + ((f) - 6) * 32 + fq * 8)
        { const int t_ = t0 + fr; const bf16_t* lp_ = zA + ((size_t)b * L + (t_ >= 0 ? t_ : 0)) * PA + 1536;
#pragma unroll
          for (int f_ = 0; f_ < 8; ++f_) { lc[f_] = ZU4; if (t_ >= 0) lc[f_] = *(const u32x4*)(lp_ + LOC(f_)); } }
#undef LOC
        SUBREP(22)
#pragma unroll
        for (int mt = 0; mt < 2; ++mt) {
            const int t = t0 + mt * 16 + fr; const bool valid = t >= 0; const size_t m = (size_t)b * L + (valid ? t : 0);
#define LOC(f) (((f) < 4) ? 128 + (f) * 32 + fq * 8 : ((f) < 6) ? ((f) - 4) * 32 + fq * 8 : 64 + ((f) - 6) * 32 + fq * 8)
#define LOLOAD(MT) do { const int t_ = t0 + (MT) * 16 + fr; const bf16_t* lp_ = zA + ((size_t)b * L + (t_ >= 0 ? t_ : 0)) * PA + 1536; \
                _Pragma("unroll") for (int f_ = 0; f_ < 8; ++f_) { lc[f_] = ZU4; if (t_ >= 0) lc[f_] = *(const u32x4*)(lp_ + LOC(f_)); } } while (0)
#define LOFRAG(dst, f, ACT) do { const f32x4 m0_ = *(const LAS f32x4*)(MUL + LOC(f)), m1_ = *(const LAS f32x4*)(MUL + LOC(f) + 4); unsigned o_[4]; \
                _Pragma("unroll") for (int i_ = 0; i_ < 4; ++i_) { const unsigned cw1_ = lc[f][i_]; const unsigned dp_ = (unsigned)__builtin_amdgcn_update_dpp(0, (int)cw1_, 0x111, 0xF, 0xF, true); const unsigned pv_ = (fr == 0) ? *(const LAS unsigned*)((mt == 0 ? bndlo : bndl + 1024) + LOC(f) * 2 + i_ * 4) : dp_; \
                    float v0_ = bflo(cw1_), v1_ = bfhi(cw1_); v0_ += (bflo(pv_) - v0_) * (i_ < 2 ? m0_[2 * i_] : m1_[2 * i_ - 4]); v1_ += (bfhi(pv_) - v1_) * (i_ < 2 ? m0_[2 * i_ + 1] : m1_[2 * i_ - 3]); \
                    if (ACT == 1) { v0_ = tanhf_(v0_); v1_ = tanhf_(v1_); } else if (ACT == 2) { v0_ = sigmoidf_(v0_); v1_ = sigmoidf_(v1_); } o_[i_] = pk2(v0_, v1_); } \
                dst = __builtin_bit_cast(bf16x8, (u32x4){o_[0], o_[1], o_[2], o_[3]}); } while (0)
            if (mt == 0) VM_WAIT();
            bf16x8 xw[2], xa[2];
            SUBREP(21) {
                bf16x8 xg[4];
#pragma unroll
                for (int ks = 0; ks < 4; ++ks) LOFRAG(xg[ks], ks, 2);
                f32x4 dg[4];
#pragma unroll
                for (int nt = 0; nt < 4; ++nt) { dg[nt] = Z4;
#pragma unroll
                    for (int ks = 0; ks < 4; ++ks) dg[nt] = MF(*(const bf16x8*)(gatT + (size_t)(wrow + 4 * nt) * 128 + ks * 32 + fq * 8), xg[ks], dg[nt]); }
                if (valid && !META) {
                    bf16_t* gp = Pg + m * 512 + h * 64 + 4 * fq;
#pragma unroll
                    for (int nt = 0; nt < 4; ++nt) *(u32x2*)(gp + 16 * nt) = (u32x2){pk2(dg[nt][0], dg[nt][1]), pk2(dg[nt][2], dg[nt][3])};
                }
            }
#pragma unroll
            for (int ks = 0; ks < 2; ++ks) { LOFRAG(xw[ks], 4 + ks, 1); LOFRAG(xa[ks], 6 + ks, 0); }
            __builtin_amdgcn_sched_barrier(0);
            f32x4 dw[4], da[4];
#pragma unroll
            for (int nt = 0; nt < 4; ++nt) { dw[nt] = Z4; da[nt] = Z4;
#pragma unroll
                for (int ks = 0; ks < 2; ++ks) {
                    dw[nt] = MF(*(const bf16x8*)(decT + (size_t)(wrow + 4 * nt) * 64 + ks * 32 + fq * 8), xw[ks], dw[nt]);
                    da[nt] = MF(*(const bf16x8*)(iclT + (size_t)(wrow + 4 * nt) * 64 + ks * 32 + fq * 8), xa[ks], da[nt]); } }
#undef LOFRAG
            __builtin_amdgcn_sched_barrier(0);
            const int colb = h * 64 + 16 * fq;
#define PREVW(q, w) ({ const unsigned cw_ = cur[mt][q][(w) >> 2][(w) & 3]; unsigned pw_ = (unsigned)__builtin_amdgcn_update_dpp(0, (int)cw_, 0x111, 0xF, 0xF, true); \
                       const unsigned ew_ = (mt == 0) ? *(const LAS unsigned*)(bndl + (q) * 128 + fq * 32 + (w) * 4) : (unsigned)__shfl((int)cur[0][q][(w) >> 2][(w) & 3], lz | 15); (fr == 0) ? ew_ : pw_; })
#define PRMV(q, nt) (*(const LAS f32x4*)(PRM + (q) * 512 + colb + 4 * (nt)))
            float ss = 0.f, cs = 0.f; unsigned cvw[8];
#pragma unroll
            for (int nt = 0; nt < 4; ++nt) {
                const unsigned c0 = cur[mt][1][(2 * nt) >> 2][(2 * nt) & 3], c1 = cur[mt][1][(2 * nt + 1) >> 2][(2 * nt + 1) & 3], p0 = PREVW(1, 2 * nt), p1 = PREVW(1, 2 * nt + 1);
                const f32x4 muk = PRMV(1, nt), kkv = PRMV(5, nt);
                const f32x4 kcv = (f32x4){bflo(c0), bfhi(c0), bflo(c1), bfhi(c1)}, kpv = (f32x4){bflo(p0), bfhi(p0), bflo(p1), bfhi(p1)};
                const f32x4 kz = kcv + (kpv - kcv) * muk;
                const f32x4 kq = kz * kkv; ss += (kq[0] * kq[0] + kq[1] * kq[1]) + (kq[2] * kq[2] + kq[3] * kq[3]);
            }
            ss += __shfl_xor(ss, 16); ss += __shfl_xor(ss, 32);
            const float inv = 1.f / fmaxf(sqrtf(ss), 1e-12f);
#pragma unroll
            for (int nt = 0; nt < 4; ++nt) {
                const unsigned rc0 = cur[mt][0][(2 * nt) >> 2][(2 * nt) & 3], rc1 = cur[mt][0][(2 * nt + 1) >> 2][(2 * nt + 1) & 3], rp0 = PREVW(0, 2 * nt), rp1 = PREVW(0, 2 * nt + 1);
                const unsigned vc0 = cur[mt][2][(2 * nt) >> 2][(2 * nt) & 3], vc1 = cur[mt][2][(2 * nt + 1) >> 2][(2 * nt + 1) & 3], vp0 = PREVW(2, 2 * nt), vp1 = PREVW(2, 2 * nt + 1);
                const unsigned kc0 = cur[mt][1][(2 * nt) >> 2][(2 * nt) & 3], kc1 = cur[mt][1][(2 * nt + 1) >> 2][(2 * nt + 1) & 3], kp0 = PREVW(1, 2 * nt), kp1 = PREVW(1, 2 * nt + 1);
                const f32x4 kcv = (f32x4){bflo(kc0), bfhi(kc0), bflo(kc1), bfhi(kc1)}, kpv = (f32x4){bflo(kp0), bfhi(kp0), bflo(kp1), bfhi(kp1)};
                const f32x4 kz = kcv + (kpv - kcv) * PRMV(1, nt);
                const f32x4 mur = PRMV(0, nt), muv = PRMV(2, nt), w0v = PRMV(3, nt), a0v = PRMV(4, nt), kkv = PRMV(5, nt), kav = PRMV(6, nt), rkv = PRMV(7, nt);
                const f32x4 rcv = (f32x4){bflo(rc0), bfhi(rc0), bflo(rc1), bfhi(rc1)}, rpv = (f32x4){bflo(rp0), bfhi(rp0), bflo(rp1), bfhi(rp1)};
                const f32x4 vcv = (f32x4){bflo(vc0), bfhi(vc0), bflo(vc1), bfhi(vc1)}, vpv = (f32x4){bflo(vp0), bfhi(vp0), bflo(vp1), bfhi(vp1)};
                const f32x4 r4 = rcv + (rpv - rcv) * mur, v4 = vcv + (vpv - vcv) * muv;
                f32x4 Rh, Ah, Bh, Kh;
#pragma unroll
                for (int j = 0; j < 4; ++j) {
                    const float a = sigmoidf_(a0v[j] + da[nt][j]);
                    const float lw = valid ? -0.8750387749145276f * sigmoidf_(w0v[j] + dw[nt][j]) : 0.f;
                    const float kk = kz[j] * kkv[j] * inv, kn = kz[j] * (1.f + (a - 1.f) * kav[j]);
                    cs += r4[j] * kn * rkv[j];
                    float x = lw;
                    x += DPP_SHR(x, 1); x += DPP_SHR(x, 2); x += DPP_SHR(x, 4); x += DPP_SHR(x, 8);
                    if (mt == 1) x += Tm[nt * 16 + fq * 4 + j];
                    const float ep = __builtin_amdgcn_exp2f(x), em = __builtin_amdgcn_rcpf(ep), epv = __builtin_amdgcn_exp2f(x - lw);
                    Rh[j] = r4[j] * ep; Ah[j] = -kk * epv; Bh[j] = kk * a * em; Kh[j] = kn * em;
                    if (fr == 15) { if (mt == 0) Tm[nt * 16 + fq * 4 + j] = x; else gC[nt * 16 + fq * 4 + j] = ep; }
                }
                R2[mt][nt] = (u32x2){pk2(Rh[0], Rh[1]), pk2(Rh[2], Rh[3])};
                const u32x2 vw = (u32x2){pk2(v4[0], v4[1]), pk2(v4[2], v4[3])};
                *(u32x2*)(slotb + SL_V + nt * 1024 + (mt * 16 + fr) * 32 + fq * 8) = vw;
                cvw[2 * nt] = vw.x; cvw[2 * nt + 1] = vw.y;
                const int off = (mt * 16 + fr) * 144 + (nt * 16 + fq * 4) * 2;
                *(LAS u32x2*)(Al + off) = (u32x2){pk2(Ah[0], Ah[1]), pk2(Ah[2], Ah[3])}; *(LAS u32x2*)(Bl + off) = (u32x2){pk2(Bh[0], Bh[1]), pk2(Bh[2], Bh[3])};
                *(LAS u32x2*)(Kl + off) = (u32x2){pk2(Kh[0], Kh[1]), pk2(Kh[2], Kh[3])};
                __builtin_amdgcn_sched_barrier(0);
            }
#undef PREVW
#undef PRMV
            if (mt == 0) { CURLOAD(1); LOLOAD(1); }
            cs += __shfl_xor(cs, 16); cs += __shfl_xor(cs, 32);
            if (valid && !META) {
                unsigned cw[8];
#pragma unroll
                for (int q = 0; q < 8; ++q) cw[q] = pk2(cs * bflo(cvw[q]), cs * bfhi(cvw[q]));
                bf16_t* cp = Pcv + m * 512 + h * 64 + 4 * fq;
#pragma unroll
                for (int nt = 0; nt < 4; ++nt) *(u32x2*)(cp + 16 * nt) = (u32x2){cw[2 * nt], cw[2 * nt + 1]};
            }
        }
#undef LOLOAD
#undef LOC
#undef CURLOAD
#define FRG(X2, mt, ks) __builtin_bit_cast(bf16x8, (u32x4){X2[mt][2 * (ks)].x, X2[mt][2 * (ks)].y, X2[mt][2 * (ks) + 1].x, X2[mt][2 * (ks) + 1].y})
#define Rf(mt, ks) FRG(R2, mt, ks)
#define FRL(XL, mt, ks) ({ const LAS unsigned char* p_ = (XL) + ((mt) * 16 + fr) * 144 + (32 * (ks) + 4 * fq) * 2; const u32x2 a_ = *(const LAS u32x2*)p_, b_ = *(const LAS u32x2*)(p_ + 32); __builtin_bit_cast(bf16x8, (u32x4){a_.x, a_.y, b_.x, b_.y}); })
#define Af(mt, ks) FRL(Al, mt, ks)
#define Bf(mt, ks) FRL(Bl, mt, ks)
#define Kf(mt, ks) FRL(Kl, mt, ks)
        __builtin_amdgcn_sched_barrier(0);
        const int ri = 4 * fq, cj = fr;
        f32x4 Mak00, Mak10, Mak11, Mrb00, Mrb01, Mrb11, Mrk00, Mrk01, Mrk11;
        {
            f32x4 m00 = MF(Af(0, 0), Bf(0, 0), Z4); m00 = MF(Af(0, 1), Bf(0, 1), m00);
            f32x4 m10 = MF(Af(1, 0), Bf(0, 0), Z4); m10 = MF(Af(1, 1), Bf(0, 1), m10);
            f32x4 m11 = MF(Af(1, 0), Bf(1, 0), Z4); m11 = MF(Af(1, 1), Bf(1, 1), m11);
#pragma unroll
            for (int rg = 0; rg < 4; ++rg) {
                const bool lo = (ri + rg) > cj;
                Tm[(ri + rg) * 32 + cj] = lo ? m00[rg] : 0.f; Tm[(16 + ri + rg) * 32 + cj] = m10[rg]; Tm[(16 + ri + rg) * 32 + 16 + cj] = lo ? m11[rg] : 0.f;
                Tm[(ri + rg) * 32 + 16 + cj] = 0.f;
            }
            Mak00 = MF(Af(0, 0), Kf(0, 0), Z4); Mak00 = MF(Af(0, 1), Kf(0, 1), Mak00);
            Mak10 = MF(Af(1, 0), Kf(0, 0), Z4); Mak10 = MF(Af(1, 1), Kf(0, 1), Mak10);
            Mak11 = MF(Af(1, 0), Kf(1, 0), Z4); Mak11 = MF(Af(1, 1), Kf(1, 1), Mak11);
            Mrb00 = MF(Bf(0, 0), Rf(0, 0), Z4); Mrb00 = MF(Bf(0, 1), Rf(0, 1), Mrb00);
            Mrb01 = MF(Bf(0, 0), Rf(1, 0), Z4); Mrb01 = MF(Bf(0, 1), Rf(1, 1), Mrb01);
            Mrb11 = MF(Bf(1, 0), Rf(1, 0), Z4); Mrb11 = MF(Bf(1, 1), Rf(1, 1), Mrb11);
            Mrk00 = MF(Kf(0, 0), Rf(0, 0), Z4); Mrk00 = MF(Kf(0, 1), Rf(0, 1), Mrk00);
            Mrk01 = MF(Kf(0, 0), Rf(1, 0), Z4); Mrk01 = MF(Kf(0, 1), Rf(1, 1), Mrk01);
            Mrk11 = MF(Kf(1, 0), Rf(1, 0), Z4); Mrk11 = MF(Kf(1, 1), Rf(1, 1), Mrk11);
#pragma unroll
            for (int rg = 0; rg < 4; ++rg) {
                const bool lo = (ri + rg) > cj, up = cj >= (ri + rg);
                Mak00[rg] = lo ? Mak00[rg] : 0.f; Mak11[rg] = lo ? Mak11[rg] : 0.f;
                Mrb00[rg] = up ? Mrb00[rg] : 0.f; Mrb11[rg] = up ? Mrb11[rg] : 0.f; Mrk00[rg] = up ? Mrk00[rg] : 0.f; Mrk11[rg] = up ? Mrk11[rg] : 0.f;
            }
        }
        __builtin_amdgcn_sched_barrier(0);
        {
            const int cc = lz & 31; float tt[32];
#pragma unroll
            for (int i = 0; i < 32; ++i) tt[i] = 0.f;
            LDS_WAIT(); asm volatile("" ::: "memory");
#pragma unroll
            for (int i = 0; i < 32; ++i) {
                float acc = (cc == i) ? 1.f : 0.f;
#pragma unroll
                for (int j4 = 0; j4 < (i + 3) / 4; ++j4) { const f32x4 mm = *(const LAS f32x4*)(Tm + i * 32 + 4 * j4); acc += (mm.x * tt[4 * j4] + mm.y * tt[4 * j4 + 1]) + (mm.z * tt[4 * j4 + 2] + mm.w * tt[4 * j4 + 3]); }
                tt[i] = acc;
                Tm[i * 32 + cc] = acc;
            }
            LDS_WAIT(); asm volatile("" ::: "memory");
        }
        __builtin_amdgcn_sched_barrier(0);
        bf16x8 Atf[4];
        {
            bf16x8 Tn[2];
#pragma unroll
            for (int ti = 0; ti < 2; ++ti) { const LAS float* tp = Tm + (16 * ti + fr) * 32 + 8 * fq; const f32x4 ta = *(const LAS f32x4*)tp, tb = *(const LAS f32x4*)(tp + 4); Tn[ti] = packf(ta, tb); }
#pragma unroll
            for (int kt = 0; kt < 4; ++kt) {
                const LAS unsigned char* ap = Al + (8 * fq + (fr >> 2)) * 144 + (16 * kt + 4 * (fr & 3)) * 2;
                const bf16x8 atr = tr8(ap, ap + 4 * 144);
                Atf[kt] = packf(MF(Tn[0], atr, Z4), MF(Tn[1], atr, Z4));
            }
        }
        bf16x8 TMf[2], MrbTf[2];
        {
            bf16x8 Tp[2];
#pragma unroll
            for (int ti = 0; ti < 2; ++ti) { const LAS float* tp = Tm + (16 * ti + fr) * 32 + 4 * fq; const f32x4 ta = *(const LAS f32x4*)tp, tb = *(const LAS f32x4*)(tp + 16); Tp[ti] = packf(ta, tb); }
            const bf16x8 MakB0 = packf(Mak00, Mak10), MakB1 = packf(Z4, Mak11);
            const f32x4 TM00 = MF(Tp[0], MakB0, Z4), TM10 = MF(Tp[1], MakB0, Z4), TM11 = MF(Tp[1], MakB1, Z4);
            TMf[0] = packf(TM00, TM10); TMf[1] = packf(Z4, TM11);
            MrbTf[0] = packf(Mrb00, Z4); MrbTf[1] = packf(Mrb01, Mrb11);
        }
        unsigned char* slot = slotb + lz * 16;
        __builtin_amdgcn_sched_barrier(0);
#pragma unroll
        for (int ti = 0; ti < 2; ++ti)
#pragma unroll
            for (int ks = 0; ks < 2; ++ks) {
                const u32x2 ra = R2[ti][2 * ks], rb = R2[ti][2 * ks + 1];
                const f32x4 w0t = MF(Atf[2 * ks], MrbTf[ti], ((f32x4){bflo(ra.x), bfhi(ra.x), bflo(ra.y), bfhi(ra.y)})), w1t = MF(Atf[2 * ks + 1], MrbTf[ti], ((f32x4){bflo(rb.x), bfhi(rb.x), bflo(rb.y), bfhi(rb.y)}));
                *(bf16x8*)(slot + SL_WQ + (ti * 2 + ks) * 1024) = packf(w0t, w1t);
            }
        {
            const f32x4 q00 = MF(TMf[0], MrbTf[0], Mrk00), q01 = MF(TMf[0], MrbTf[1], Mrk01), q11 = MF(TMf[1], MrbTf[1], Mrk11);
            *(bf16x8*)(slot + SL_AQK) = packf(q00, Z4);
            *(bf16x8*)(slot + SL_AQK + 1024) = packf(q01, q11);
        }
        __builtin_amdgcn_sched_barrier(0);
        SUBREP(24) {
            const int dd = fr - 4 * fq; unsigned iw[4];
#pragma unroll
            for (int q = 0; q < 4; ++q) iw[q] = (dd == q) ? 0x3F80u : 0u;
            const unsigned ilo = iw[0] | (iw[1] << 16), ihi = iw[2] | (iw[3] << 16);
            const bf16x8 If0 = __builtin_bit_cast(bf16x8, (u32x4){ilo, ihi, 0u, 0u}), If1 = __builtin_bit_cast(bf16x8, (u32x4){0u, 0u, ilo, ihi});
            LDS_WAIT(); asm volatile("" ::: "memory");
#pragma unroll
            for (int kt = 0; kt < 4; ++kt) {
                const int toff = (4 * fq + (fr >> 2)) * 144 + (16 * kt + 4 * (fr & 3)) * 2;
                const bf16x8 btr = tr8(Bl + toff, Bl + toff + 16 * 144), ktr = tr8(Kl + toff, Kl + toff + 16 * 144);
                const float gc = gC[16 * kt + fr];
                f32x4 g4[4];
#pragma unroll
                for (int k2 = 0; k2 < 4; ++k2) {
                    g4[k2] = MF(Atf[k2], btr, Z4);
#pragma unroll
                    for (int rg = 0; rg < 4; ++rg) g4[k2][rg] = (g4[k2][rg] + ((16 * k2 + ri + rg) == (16 * kt + cj) ? 1.f : 0.f)) * gc;
                }
                *(bf16x8*)(slot + SL_G + (kt * 2 + 0) * 1024) = packf(g4[0], g4[1]);
                *(bf16x8*)(slot + SL_G + (kt * 2 + 1) * 1024) = packf(g4[2], g4[3]);
                f32x4 k0 = MF(TMf[0], btr, Z4), k1 = MF(TMf[1], btr, Z4);
                k0 = MF(If0, ktr, k0); k1 = MF(If1, ktr, k1);
                *(bf16x8*)(slot + SL_KT + kt * 1024) = packf(k0 * gc, k1 * gc);
                __builtin_amdgcn_sched_barrier(0);
            }
        }
    }
}

#undef FRG
#undef FRL
#undef Rf
#undef Af
#undef Bf
#undef Kf

__device__ __forceinline__ void moe_weight_copies(const Params& p, LAS float* scr, int lane, int gw, int NGW) {
    unsigned char* Wgu = (unsigned char*)p.out; unsigned char* Wd = (unsigned char*)p.out + (size_t)NE * 1024 * 1024;
    MapId id;
#define MW_SRC(it, W_, N_, r_) const int e_##it = (it) / 384, q_##it = (it) - e_##it * 384; const float* W_ = (q_##it < 128) ? p.in[22] + (size_t)e_##it * 1024 * 512 : (q_##it < 256) ? p.in[23] + (size_t)e_##it * 1024 * 512 : p.in[24] + (size_t)e_##it * 512 * 1024; \
    const int N_ = (q_##it < 256) ? 512 : 1024, r_ = (q_##it < 128) ? q_##it : (q_##it < 256) ? q_##it - 128 : q_##it - 256
    f32x4 va[16], vb[16];
    int it = gw;
    if (it < NE * 384) { MW_SRC(it, W0, N0, r0); tr_load(W0, N0, r0, lane, va); }
    for (; it < NE * 384; it += 2 * NGW) {
        const int it2 = it + NGW, it3 = it + 2 * NGW;
        if (it2 < NE * 384) { MW_SRC(it2, W1, N1, r1); tr_load(W1, N1, r1, lane, vb); }
        {
            const int e = it / 384, q = it - e * 384;
            if (q < 128) { MapGU mg{0}; tr_store<false, true>(va, 1024, 512, (bf16_t*)(Wgu + (size_t)e * 1024 * 1024), mg, p.in[17], scr, q, lane); }
            else if (q < 256) { MapGU mu{1}; tr_store<false, true>(va, 1024, 512, (bf16_t*)(Wgu + (size_t)e * 1024 * 1024), mu, p.in[17], scr, q - 128, lane); }
            else tr_store<false, true>(va, 512, 1024, (bf16_t*)(Wd + (size_t)e * 1024 * 512), id, nullptr, scr, q - 256, lane);
        }
        if (it2 < NE * 384) {
            if (it3 < NE * 384) { MW_SRC(it3, W2, N2, r2); tr_load(W2, N2, r2, lane, va); }
            const int e = it2 / 384, q = it2 - e * 384;
            if (q < 128) { MapGU mg{0}; tr_store<false, true>(vb, 1024, 512, (bf16_t*)(Wgu + (size_t)e * 1024 * 1024), mg, p.in[17], scr, q, lane); }
            else if (q < 256) { MapGU mu{1}; tr_store<false, true>(vb, 1024, 512, (bf16_t*)(Wgu + (size_t)e * 1024 * 1024), mu, p.in[17], scr, q - 128, lane); }
            else tr_store<false, true>(vb, 512, 1024, (bf16_t*)(Wd + (size_t)e * 1024 * 512), id, nullptr, scr, q - 256, lane);
        }
    }
#undef MW_SRC
}
__device__ __forceinline__ void phase_rwkv_seq(const Params& p, LAS unsigned char* lds, int lane, int wid, int G, int bid) {
    unsigned char* ws = p.ws; float* Y = (float*)(ws + WS_Y);
    const int fr = lane & 15, fq = lane >> 4;
    const f32x4 Z4 = (f32x4){0.f, 0.f, 0.f, 0.f};
    constexpr int RB = 19 * 1024;
    if (wid < 2) {
        LAS unsigned char* ring = lds + wid * (3 * RB);
        for (int tb = bid; tb < 256; tb += G) {
            const int bh = (tb & 7) + 8 * (tb >> 4), vt = 2 * ((tb >> 3) & 1) + wid, b = bh >> 3, h = bh & 7;
            const unsigned char* sl = ws + WS_SLOT + (size_t)bh * NCHUNK * SLOT_BYTES + lane * 16;
            const unsigned char* sl0 = ws + WS_SLOT0 + (size_t)h * SLOT_BYTES + lane * 16;
            f32x4 Zs[4] = {Z4, Z4, Z4, Z4};
#define SEQ_ISSUE(cidx) do { const unsigned char* q_ = (((cidx) == 0) ? sl0 : sl) + (size_t)(cidx) * SLOT_BYTES; LAS unsigned char* d_ = ring + ((cidx) % 3) * RB; \
                _Pragma("unroll") for (int f = 0; f < 18; ++f) __builtin_amdgcn_global_load_lds((const unsigned*)(q_ + f * 1024), (LAS unsigned*)(d_ + f * 1024), 16, 0, 0); \
                __builtin_amdgcn_global_load_lds((const unsigned*)(q_ + SL_V + vt * 1024), (LAS unsigned*)(d_ + 18 * 1024), 16, 0, 0); } while (0)
            SEQ_ISSUE(0); SEQ_ISSUE(1);
            for (int c = 0; c < NCHUNK; ++c) {
                if (c + 2 < NCHUNK) { SEQ_ISSUE(c + 2); asm volatile("s_waitcnt vmcnt(38)" ::: "memory"); }
                else if (c + 1 < NCHUNK) asm volatile("s_waitcnt vmcnt(19)" ::: "memory");
                else asm volatile("s_waitcnt vmcnt(0)" ::: "memory");
                const LAS unsigned char* F = ring + (c % 3) * RB + lane * 16;
#define FR_(f) (*(const LAS bf16x8*)(F + (f) * 1024))
                const LAS unsigned char* vb_ = ring + (c % 3) * RB + 18 * 1024 + (4 * fq + (fr >> 2)) * 32 + (4 * (fr & 3)) * 2;
                const bf16x8 zf0 = packf(Zs[0], Zs[1]), zf1 = packf(Zs[2], Zs[3]), vf = tr8(vb_, vb_ + 16 * 32);
#pragma unroll
                for (int mt = 0; mt < 2; ++mt) {
                    f32x4 y = MF(FR_(12 + mt * 2), zf0, Z4); y = MF(FR_(13 + mt * 2), zf1, y); y = MF(FR_(16 + mt), vf, y);
#pragma unroll
                    for (int rg = 0; rg < 4; ++rg) { const int t = 32 * c - 16 + 16 * mt + 4 * fq + rg;
                        if (t >= 0) Y[((size_t)b * L + t) * 512 + h * 64 + 16 * vt + fr] = y[rg]; }
                }
#pragma unroll
                for (int kt = 0; kt < 4; ++kt) { f32x4 zn = MF(FR_(kt * 2), zf0, Z4); zn = MF(FR_(kt * 2 + 1), zf1, zn); zn = MF(FR_(8 + kt), vf, zn); Zs[kt] = zn; }
#undef FR_
            }
#undef SEQ_ISSUE
        }
    } else if (wid < 4) {
        moe_weight_copies(p, (LAS float*)(lds + 2 * 3 * RB + (wid - 2) * 16384), lane, bid * 2 + (wid - 2), G * 2);
    }
}
#undef DPP_SHR
#undef MF

__device__ __forceinline__ void phase_ret(const Params& p, LAS unsigned char* lds, int tid, int lane, int wid, int G, int bid) {
    unsigned char* ws = p.ws; const unsigned char* zB = ws + WS_ZB; bf16_t* Yb = (bf16_t*)(ws + WS_YB);
    bf16_t* sink = (bf16_t*)(ws + WS_CTL + 32768);
    constexpr int RBUF = 36864, QOFF = 0, KOFF = 16384, VOFF = 32768, NRB = 4, DUMMY = NRB * RBUF;
    const int fr = lane & 15, fq = lane >> 4, mt = wid >> 1, nt = wid & 1;
    const f32x4 Z4 = (f32x4){0.f, 0.f, 0.f, 0.f};
    for (int job = bid; job < 256; job += G) {
        const int bh = (job & 7) + 8 * (job >> 5), dvb = (job >> 3) & 3, b = bh >> 2, h = bh & 3;
        const float lg2 = ret_lg2(h), g1 = __builtin_amdgcn_exp2f(lg2), g63 = __builtin_amdgcn_exp2f(63.f * lg2);
        const unsigned char* zrow0 = zB + (size_t)b * L * (PB * 2);
        const int rq0 = 4 * wid + (lane >> 4), rq1 = rq0 + 32, rv = 16 * (wid & 3) + (lane >> 2);
        const unsigned char* pq0 = zrow0 + (ptrdiff_t)(rq0 - 48) * (PB * 2) + h * 256 + (((lane & 15) ^ (rq0 & 15)) << 4);
        const unsigned char* pq1 = zrow0 + (ptrdiff_t)(rq1 - 48) * (PB * 2) + h * 256 + (((lane & 15) ^ (rq1 & 15)) << 4);
        const unsigned char* pv = zrow0 + (ptrdiff_t)(rv - 48) * (PB * 2) + 2048 + h * 256 + dvb * 64 + ((lane & 3) << 4);
        const int dq0 = QOFF + wid * 1024, dq1 = QOFF + (wid + 8) * 1024, dv = VOFF + (wid & 3) * 1024;
#define RET_GLDS(src, dstoff, imm) __builtin_amdgcn_global_load_lds((const unsigned*)((src) + (imm)), (LAS unsigned*)(lds + (dstoff)), 16, 0, 0)
        __syncthreads();
        for (int i = tid; i < 1728; i += 512) {
            const int o = (i < 768) ? QOFF + i * 16 : (i < 1536) ? KOFF + (i - 768) * 16 : VOFF + (i - 1536) * 16;
            *(LAS u32x4*)(lds + o) = (u32x4){0u, 0u, 0u, 0u};
        }
        {
            const bool q0ok = wid >= 12, q1ok = wid + 8 >= 12, vok = (wid == 3);
            const unsigned char* safe = zrow0 + h * 256 + ((lane & 15) << 4);
            RET_GLDS(q0ok ? pq0 : safe, q0ok ? dq0 : DUMMY, 0); RET_GLDS(q0ok ? pq0 : safe, q0ok ? KOFF + dq0 : DUMMY, 1024);
            RET_GLDS(q1ok ? pq1 : safe, q1ok ? dq1 : DUMMY, 0); RET_GLDS(q1ok ? pq1 : safe, q1ok ? KOFF + dq1 : DUMMY, 1024);
            RET_GLDS(vok ? pv : safe, vok ? dv : DUMMY, 0);
        }
        const size_t CSTEP = (size_t)64 * PB * 2;
#define RET_ISSUE(cc) do { const int bo_ = ((cc) & 3) * RBUF; const bool rl_ = (cc) < 33; const unsigned char* q0_ = pq0 + (size_t)(cc) * CSTEP; const unsigned char* q1_ = pq1 + (size_t)(cc) * CSTEP; const unsigned char* v_ = pv + (size_t)(cc) * CSTEP; \
            RET_GLDS(q0_, rl_ ? bo_ + dq0 : DUMMY, 0); RET_GLDS(q0_, rl_ ? bo_ + KOFF + dq0 : DUMMY, 1024); RET_GLDS(q1_, rl_ ? bo_ + dq1 : DUMMY, 0); RET_GLDS(q1_, rl_ ? bo_ + KOFF + dq1 : DUMMY, 1024); \
            RET_GLDS(v_, (rl_ && wid < 4) ? bo_ + dv : DUMMY, 0); } while (0)
        RET_ISSUE(1); RET_ISSUE(2);
        const int ri = 16 * mt + fr;
        const int oq = QOFF + ri * 256 + ((fq ^ (ri & 3)) << 4) + (((ri >> 2) & 3) << 6);
        const int ok = KOFF + fr * 256 + ((fq ^ (fr & 3)) << 4) + (((fr >> 2) & 3) << 6);
        const int oqp = QOFF + ri * 256 + (((fq >> 1) ^ (ri & 3)) << 4) + (((ri >> 2) & 3) << 6) + 8 * (fq & 1);
        const int rw = 4 * fq + (fr >> 2);
        const int okt = KOFF + rw * 256 + ((((fr >> 1) & 1) ^ (rw & 3)) << 4) + (((rw >> 2) & 3) << 6) + 8 * (fr & 1);
        const int ovt = VOFF + rw * 64 + (16 * nt + 4 * (fr & 3)) * 2;
        f32x4 R[8];
#pragma unroll
        for (int dt = 0; dt < 8; ++dt) R[dt] = Z4;
        for (int c = 0; c < 33; ++c) {
            if (c == 0) asm volatile("s_waitcnt vmcnt(10) lgkmcnt(0)" ::: "memory"); else if (c == 1) asm volatile("s_waitcnt vmcnt(14) lgkmcnt(0)" ::: "memory"); else asm volatile("s_waitcnt vmcnt(18) lgkmcnt(0)" ::: "memory");
            __builtin_amdgcn_s_barrier();
            asm volatile("" ::: "memory");
            RET_ISSUE(c + 3);
            const LAS unsigned char* B0 = lds + (c & 3) * RBUF;
            bf16x8 qn[4];
#pragma unroll
            for (int ks = 0; ks < 4; ++ks) qn[ks] = *(const LAS bf16x8*)(B0 + (oq ^ (ks << 6)));
            f32x4 ST[4];
#pragma unroll
            for (int tj = 0; tj < 4; ++tj) {
                ST[tj] = Z4;
                if (tj <= mt) {
#pragma unroll
                    for (int ks = 0; ks < 4; ++ks) ST[tj] = __builtin_amdgcn_mfma_f32_16x16x32_bf16(*(const LAS bf16x8*)(B0 + ((ok ^ (ks << 6)) + tj * 4096)), qn[ks], ST[tj], 0, 0, 0);
                    if (tj == mt) {
#pragma unroll
                        for (int rg = 0; rg < 4; ++rg) ST[tj][rg] = (fr >= 4 * fq + rg) ? ST[tj][rg] : 0.f;
                    }
                }
            }
            bf16x8 vf[2];
#pragma unroll
            for (int ks2 = 0; ks2 < 2; ++ks2) vf[ks2] = tr8(B0 + ovt + ks2 * 2048, B0 + ovt + ks2 * 2048 + 1024);
            f32x4 ai = __builtin_amdgcn_mfma_f32_16x16x32_bf16(packf(ST[0], ST[1]), vf[0], Z4, 0, 0, 0);
            if (mt >= 2) ai = __builtin_amdgcn_mfma_f32_16x16x32_bf16(packf(ST[2], ST[3]), vf[1], ai, 0, 0, 0);
            f32x4 ac = Z4;
#pragma unroll
            for (int ks = 0; ks < 4; ++ks) {
                const u32x2 a0 = *(const LAS u32x2*)(B0 + (oqp ^ (ks << 6))), a1 = *(const LAS u32x2*)(B0 + (oqp ^ (ks << 6) ^ 32));
                ac = __builtin_amdgcn_mfma_f32_16x16x32_bf16(__builtin_bit_cast(bf16x8, (u32x4){a0.x, a0.y, a1.x, a1.y}), packf(R[2 * ks], R[2 * ks + 1]), ac, 0, 0, 0);
            }
#pragma unroll
            for (int rg = 0; rg < 4; ++rg) {
                const int t = 64 * c - 48 + 16 * mt + 4 * fq + rg;
                bf16_t* dst = (t >= 0) ? Yb + ((size_t)b * L + t) * 512 + h * 128 + dvb * 32 + 16 * nt + fr : sink + tid;
                *dst = (bf16_t)f2bf(ai[rg] + g1 * ac[rg]);
            }
#pragma unroll
            for (int dt = 0; dt < 8; ++dt) {
                f32x4 r = R[dt] * g1;
#pragma unroll
                for (int ks2 = 0; ks2 < 2; ++ks2) {
                    const LAS unsigned char* kp = B0 + ((okt ^ (dt << 5)) + ks2 * 8192);
                    r = __builtin_amdgcn_mfma_f32_16x16x32_bf16(tr8(kp, kp + 4096), vf[ks2], r, 0, 0, 0);
                }
                R[dt] = r * g63;
            }
        }
        VM_WAIT();
#undef RET_ISSUE
#undef RET_GLDS
    }
}

__device__ __forceinline__ void phase_post(const Params& p, int lane, int wid, int G, int bid) {
    unsigned char* ws = p.ws;
    const float* Y = (const float*)(ws + WS_Y); const bf16_t* Yb = (const bf16_t*)(ws + WS_YB); const bf16_t* zB = (const bf16_t*)(ws + WS_ZB);
    const bf16_t* Pv = (const bf16_t*)(ws + WS_CV); const bf16_t* Pg = (const bf16_t*)(ws + WS_G2);
    const float* lnw = p.in[13]; const float* lnb = p.in[14]; const float* gnw = p.in[15];
    bf16_t* mixed = (bf16_t*)(ws + WS_MIXED);
    const bool isA = lane < 32;
    for (int m2 = bid * 8 + wid; m2 < M2; m2 += G * 8) {
        const int b = m2 >> 11, s = m2 & 2047; const size_t m1 = (size_t)b * L + NMETA + s;
        float y[16];
        if (isA) {
            const float* yp = Y + m1 * 512 + lane * 16;
#pragma unroll
            for (int q = 0; q < 4; ++q) { const f32x4 v = *(const f32x4*)(yp + 4 * q); y[4 * q] = v.x; y[4 * q + 1] = v.y; y[4 * q + 2] = v.z; y[4 * q + 3] = v.w; }
        } else {
            const bf16_t* yp = Yb + m1 * 512 + (lane - 32) * 16;
            const u32x4 v0 = *(const u32x4*)yp, v1 = *(const u32x4*)(yp + 8);
#pragma unroll
            for (int q = 0; q < 4; ++q) { y[2 * q] = bflo(v0[q]); y[2 * q + 1] = bfhi(v0[q]); y[8 + 2 * q] = bflo(v1[q]); y[8 + 2 * q + 1] = bfhi(v1[q]); }
        }
        float sm = 0.f;
#pragma unroll
        for (int i = 0; i < 16; ++i) sm += y[i];
        float s4 = sm + __shfl_xor(sm, 1); s4 += __shfl_xor(s4, 2); const float s8 = s4 + __shfl_xor(s4, 4);
        const float mean = isA ? s4 * (1.f / 64.f) : s8 * (1.f / 128.f);
        float sv = 0.f;
#pragma unroll
        for (int i = 0; i < 16; ++i) { y[i] -= mean; sv += y[i] * y[i]; }
        float v4 = sv + __shfl_xor(sv, 1); v4 += __shfl_xor(v4, 2); const float v8 = v4 + __shfl_xor(v4, 4);
        const float rstd = isA ? 1.f / sqrtf(v4 * (1.f / 64.f) + 64e-5f) : 1.f / sqrtf(v8 * (1.f / 128.f) + 1e-5f);
        float o[16];
        if (isA) {
            const int col = lane * 16;
            const u32x4 va = *(const u32x4*)(Pv + m1 * 512 + col), vb = *(const u32x4*)(Pv + m1 * 512 + col + 8);
            const u32x4 ga = *(const u32x4*)(Pg + m1 * 512 + col), gb = *(const u32x4*)(Pg + m1 * 512 + col + 8);
#pragma unroll
            for (int i = 0; i < 16; ++i) {
                const unsigned vw = i < 8 ? va[(i >> 1) & 3] : vb[(i >> 1) & 3], gw = i < 8 ? ga[(i >> 1) & 3] : gb[(i >> 1) & 3];
                const float v = (i & 1) ? bfhi(vw) : bflo(vw), g = (i & 1) ? bfhi(gw) : bflo(gw);
                const int ac = (col & ~63) + 16 * (i >> 2) + 4 * (lane & 3) + (i & 3);
                o[i] = (y[i] * rstd * lnw[ac] + lnb[ac] + v) * g;
            }
        } else {
            const int cb = (lane - 32) * 16;
            const u32x4 ga = *(const u32x4*)(zB + m1 * PB + 1536 + cb), gb = *(const u32x4*)(zB + m1 * PB + 1536 + cb + 8);
#pragma unroll
            for (int i = 0; i < 16; ++i) {
                const unsigned gw = i < 8 ? ga[(i >> 1) & 3] : gb[(i >> 1) & 3];
                const float g = (i & 1) ? bfhi(gw) : bflo(gw);
                o[i] = y[i] * rstd * gnw[cb + i] * (g * sigmoidf_(g));
            }
        }
        bf16_t* op = mixed + (size_t)m2 * 1024 + lane * 16;
        *(u32x4*)op = (u32x4){pk2(o[0], o[1]), pk2(o[2], o[3]), pk2(o[4], o[5]), pk2(o[6], o[7])};
        *(u32x4*)(op + 8) = (u32x4){pk2(o[8], o[9]), pk2(o[10], o[11]), pk2(o[12], o[13]), pk2(o[14], o[15])};
    }
}

struct EpiH2 {
    static constexpr bool PERM = true;
    bf16_t* hmid; const float* x; unsigned char* u8;
    __device__ __forceinline__ void operator()(const f32x4 (&acc)[2][2][4][2], const pg8::DenseOrder::Unit& u, int wr, int wc, int fr, int fq) const {
        const int row0 = u.pm * 256 + wr * 64 + fr, col0 = u.pn * 256 + wc * 32 + 8 * fq;
#pragma unroll
        for (int ai = 0; ai < 2; ++ai)
#pragma unroll
            for (int m = 0; m < 4; ++m) {
                const size_t off = (size_t)(row0 + ai * 128 + m * 16) * D + col0;
#pragma unroll
                for (int bj = 0; bj < 2; ++bj) {
                    const f32x4 v0 = *(const f32x4*)(x + off + bj * 128) + acc[ai][bj][m][0], v1 = *(const f32x4*)(x + off + bj * 128 + 4) + acc[ai][bj][m][1];
                    *(u32x4*)(hmid + off + bj * 128) = (u32x4){pk2(v0[0], v0[1]), pk2(v0[2], v0[3]), pk2(v1[0], v1[1]), pk2(v1[2], v1[3])};
                    *(u32x2*)(u8 + off + bj * 128) = (u32x2){pk4_fp8(v0[0], v0[1], v0[2], v0[3]), pk4_fp8(v1[0], v1[1], v1[2], v1[3])};
                }
            }
    }
};
__device__ __forceinline__ void phase5(const Params& p, LAS unsigned char* lds, int tid, int lane, int wid, int G, int bid) {
    unsigned char* ws = p.ws;
    {
        pg8::DenseOrder S; S.init((const bf16_t*)(ws + WS_MIXED), (const bf16_t*)(ws + WS_WOUT), M2, D, D, G, bid);
        EpiH2 E{(bf16_t*)(ws + WS_HMID), p.in[0], ws + WS_U8};
        pg8::gemm_phase<EpiH2, pg8::DenseOrder, true>(lds, S, E);
    }
}

__device__ __forceinline__ void phase6(const Params& p, LAS unsigned char* lds, int tid, int lane, int wid, int G, int bid) {
    unsigned char* ws = p.ws;
    const bf16_t* hmid = (const bf16_t*)(ws + WS_HMID); const unsigned char* Wr = ws + WS_WR;
    float* rstd2 = (float*)(ws + RT_RSTD2);
    int* asg_e = (int*)(ws + RT_E); float* asg_w = (float*)(ws + RT_W); int* asg_pos = (int*)(ws + RT_POS); int* cntT = (int*)(ws + RT_CNT);
    const float* brg = p.in[19]; const float* bre = p.in[21];
    const int fr = lane & 15, fq = lane >> 4;
    constexpr int WP = 2064, WLO = 36 * WP;
    LAS int* elist = (LAS int*)(lds + 2 * WLO);
    __syncthreads();
    for (int i = tid; i < 2 * 36 * 128; i += 512) {
        const int pl = i / (36 * 128), r = (i / 128) % 36, c = i & 127;
        *(LAS u32x4*)(lds + pl * WLO + r * WP + c * 16) = *(const u32x4*)(Wr + (size_t)pl * 36 * 2048 + r * 2048 + c * 16);
    }
    __syncthreads();
    const f32x4 Z4 = (f32x4){0.f, 0.f, 0.f, 0.f};
    for (int unit = bid; unit < 256; unit += G) {
        const int m2 = unit * 128 + wid * 16 + fr;
        f32x4 acc[3] = {Z4, Z4, Z4};
        float ss = 0.f;
        const bf16_t* hp = hmid + (size_t)m2 * D + 8 * fq;
        int wrow[3];
#pragma unroll
        for (int nt = 0; nt < 3; ++nt) wrow[nt] = min(16 * nt + fr, 35) * WP + 16 * fq;
#pragma unroll 4
        for (int ks = 0; ks < 32; ++ks) {
            const u32x4 hw = *(const u32x4*)(hp + 32 * ks);
#pragma unroll
            for (int q = 0; q < 4; ++q) { const float a = bflo(hw[q]), b = bfhi(hw[q]); ss += a * a + b * b; }
            const bf16x8 hb = __builtin_bit_cast(bf16x8, hw);
#pragma unroll
            for (int nt = 0; nt < 3; ++nt) {
                acc[nt] = __builtin_amdgcn_mfma_f32_16x16x32_bf16(*(const LAS bf16x8*)(lds + wrow[nt] + 64 * ks), hb, acc[nt], 0, 0, 0);
                acc[nt] = __builtin_amdgcn_mfma_f32_16x16x32_bf16(*(const LAS bf16x8*)(lds + WLO + wrow[nt] + 64 * ks), hb, acc[nt], 0, 0, 0);
            }
        }
        ss += __shfl_xor(ss, 16); ss += __shfl_xor(ss, 32);
        const float rs = 1.f / sqrtf(ss * (1.f / D) + 1e-6f);
        if (fq == 0) rstd2[m2] = rs;
        float gl[4];
#pragma unroll
        for (int j = 0; j < 4; ++j) gl[j] = acc[0][j] * rs + brg[j];
        int gi = 0; float gm = gl[0];
#pragma unroll
        for (int j = 1; j < 4; ++j) if (gl[j] > gm) { gm = gl[j]; gi = j; }
        gi = __shfl(gi, fr);
        float el[8];
#pragma unroll
        for (int half = 0; half < 2; ++half) {
            const int q = 1 + 2 * gi + half, snt = q >> 2, src = fr + 16 * (q & 3);
#pragma unroll
            for (int rg = 0; rg < 4; ++rg) {
                const float v0 = __shfl(acc[0][rg], src), v1 = __shfl(acc[1][rg], src), v2 = __shfl(acc[2][rg], src);
                el[4 * half + rg] = (snt == 0) ? v0 : (snt == 1) ? v1 : v2;
            }
        }
        __syncthreads();
        if (fq == 0) {
            float gs = 0.f;
#pragma unroll
            for (int j = 0; j < 4; ++j) gs += expf(gl[j] - gm);
            const float gp = 1.f / gs;
#pragma unroll
            for (int j = 0; j < 8; ++j) el[j] = el[j] * rs + bre[gi * 8 + j];
            int i1 = 0; float e1 = el[0];
#pragma unroll
            for (int j = 1; j < 8; ++j) if (el[j] > e1) { e1 = el[j]; i1 = j; }
            int i2 = -1; float e2 = -3.0e38f;
#pragma unroll
            for (int j = 0; j < 8; ++j) if (j != i1 && el[j] > e2) { e2 = el[j]; i2 = j; }
            const float p2 = expf(e2 - e1), w1 = gp / (1.f + p2), w2 = gp * p2 / (1.f + p2);
            const int a = m2 * 2;
            asg_e[a] = gi * 8 + i1; asg_e[a + 1] = gi * 8 + i2; asg_w[a] = w1; asg_w[a + 1] = w2;
            elist[(wid * 16 + fr) * 2] = gi * 8 + i1; elist[(wid * 16 + fr) * 2 + 1] = gi * 8 + i2;
        }
        __syncthreads();
        if (tid < 256) {
            const int e = elist[tid]; int pos = 0;
            for (int j = 0; j < tid; ++j) pos += (elist[j] == e) ? 1 : 0;
            asg_pos[unit * 256 + tid] = pos;
        }
        if (tid < 32) {
            int c = 0;
            for (int j = 0; j < 256; ++j) c += (elist[j] == tid) ? 1 : 0;
            cntT[unit * 32 + tid] = c;
        }
    }
}

__device__ __forceinline__ void phase7(const Params& p, LAS unsigned char* lds, int tid, int G, int bid) {
    unsigned char* ws = p.ws;
    const int* asg_e = (const int*)(ws + RT_E); const int* asg_pos = (const int*)(ws + RT_POS); const int* cntT = (const int*)(ws + RT_CNT);
    int* row_asg = (int*)(ws + RT_ROW); int* gtot = (int*)(ws + RT_TOT);
    float* row_w = (float*)(ws + RT_ROWW); float* row_rs = (float*)(ws + RT_ROWRS); const float* asg_w = (const float*)(ws + RT_W); const float* rstd2 = (const float*)(ws + RT_RSTD2);
    LAS int* tot = (LAS int*)lds; LAS int* base = tot + 32; LAS int* pst = tot + 64; LAS int* ptot = tot + 128; LAS int* pbase = tot + 128 + 512;
    for (int unit = bid; unit < 256; unit += G) {
        __syncthreads();
        {
            const int e = tid & 31, part = tid >> 5; int t = 0, bs = 0;
#pragma unroll 4
            for (int w = 16 * part; w < 16 * part + 16; ++w) { const int c = cntT[w * 32 + e]; bs += (w < unit) ? c : 0; t += c; }
            ptot[tid] = t; pbase[tid] = bs;
        }
        __syncthreads();
        if (tid < 32) {
            int t = 0, bs = 0;
#pragma unroll
            for (int q = 0; q < 16; ++q) { t += ptot[q * 32 + tid]; bs += pbase[q * 32 + tid]; }
            tot[tid] = t; base[tid] = bs;
        }
        __syncthreads();
        if (tid == 0) { int ps = 0; for (int e = 0; e < 32; ++e) { pst[e] = ps; ps += (tot[e] + 255) & ~255; } }
        __syncthreads();
        if (unit == 0 && tid < 32) { gtot[tid] = tot[tid]; gtot[32 + tid] = pst[tid]; }
        if (tid < 256) {
            const int a = unit * 256 + tid, e = asg_e[a];
            const int row = pst[e] + base[e] + asg_pos[a];
            row_asg[row] = a; row_w[row] = asg_w[a] * (1.f / 32.f); row_rs[row] = rstd2[a >> 1] * (1.f / 32.f);
        }
    }
}

template <bool GATHER_>
struct MoeOrder {
    static constexpr bool GATHER = GATHER_, FP8 = true;
    struct Unit { int e, rt, pn, nvalid, rowbase; };
    const unsigned char* A; const unsigned char* W; int K; size_t wstride; const int* row_asg; const LAS int* ltot; const LAS int* lpst; const LAS int* lcum; int NU, G, c;
    __device__ __forceinline__ bool next(int i, Unit& u) const {
        const int Lx = i * G + c; if (Lx >= NU) return false;
        int e = 0;
        for (int j = 1; j < 32; ++j) e = (Lx >= lcum[j]) ? j : e;
        e = __builtin_amdgcn_readfirstlane(e);
        const int ul = Lx - __builtin_amdgcn_readfirstlane(lcum[e]);
        u.e = e; u.rt = ul >> 2; u.pn = ul & 3; u.rowbase = __builtin_amdgcn_readfirstlane(lpst[e]) + u.rt * 256; u.nvalid = min(256, __builtin_amdgcn_readfirstlane(ltot[e]) - u.rt * 256);
        return true;
    }
    __device__ __forceinline__ const char* a_base(const Unit& u) const { return GATHER ? (const char*)A : (const char*)A + (size_t)u.rowbase * K; }
    __device__ __forceinline__ const char* b_base(const Unit& u) const { return (const char*)W + (size_t)u.e * wstride + (size_t)u.pn * 256 * K; }
    __device__ __forceinline__ void a_tok(const Unit& u, int tid, unsigned& w0, unsigned& w1) const {
        w0 = 0u; w1 = 0u;
        if (GATHER) {
            const int* rows = row_asg + u.rowbase;
#pragma unroll
            for (int i = 0; i < 2; ++i) {
                int R, C; pg8::stage_rc(tid * 16 + i * 8192, R, C);
                const unsigned a0 = (unsigned)rows[(R < u.nvalid) ? R : 0] >> 1, a1 = (unsigned)rows[(R + 128 < u.nvalid) ? R + 128 : 0] >> 1;
                w0 |= a0 << (16 * i); w1 |= a1 << (16 * i);
            }
        }
    }
};
struct EpiGU2 {
    static constexpr bool PERM = true;
    unsigned char* hid; const float* row_rs;
    __device__ __forceinline__ void operator()(const f32x4 (&acc)[2][2][4][2], const MoeOrder<true>::Unit& u, int wr, int wc, int fr, int fq) const {
        float rsv[2][4];
#pragma unroll
        for (int ai = 0; ai < 2; ++ai)
#pragma unroll
            for (int m = 0; m < 4; ++m) { const int r = ai * 128 + wr * 64 + m * 16 + fr; rsv[ai][m] = row_rs[u.rowbase + min(r, u.nvalid - 1)]; }
#pragma unroll
        for (int ai = 0; ai < 2; ++ai)
#pragma unroll
            for (int m = 0; m < 4; ++m) {
                const int r = ai * 128 + wr * 64 + m * 16 + fr;
                const float rs = rsv[ai][m];
                float o[8];
#pragma unroll
                for (int n = 0; n < 2; ++n)
#pragma unroll
                    for (int j = 0; j < 4; ++j) { const float g = acc[ai][0][m][n][j] * rs, up = acc[ai][1][m][n][j] * rs; o[n * 4 + j] = g * sigmoidf_(g) * up; }
                if (r < u.nvalid) *(u32x2*)(hid + (size_t)(u.rowbase + r) * DE + u.pn * 128 + wc * 32 + 8 * fq) = (u32x2){pk4_fp8(o[0], o[1], o[2], o[3]), pk4_fp8(o[4], o[5], o[6], o[7])};
            }
    }
};
struct EpiDown2 {
    static constexpr bool PERM = true;
    unsigned char* ym0; const int* row_asg; const float* row_w;
    __device__ __forceinline__ void operator()(const f32x4 (&acc)[2][2][4][2], const MoeOrder<false>::Unit& u, int wr, int wc, int fr, int fq) const {
        int av[2][4]; float wv[2][4];
#pragma unroll
        for (int ai = 0; ai < 2; ++ai)
#pragma unroll
            for (int m = 0; m < 4; ++m) { const int rc = u.rowbase + min(ai * 128 + wr * 64 + m * 16 + fr, u.nvalid - 1); av[ai][m] = row_asg[rc]; wv[ai][m] = row_w[rc]; }
#pragma unroll
        for (int ai = 0; ai < 2; ++ai)
#pragma unroll
            for (int m = 0; m < 4; ++m) {
                const int r = ai * 128 + wr * 64 + m * 16 + fr;
                const int a = av[ai][m]; const float w = wv[ai][m];
                unsigned char* dst = ym0 + (size_t)(a & 1) * (WS_YM1 - WS_YM0) + (size_t)(a >> 1) * D + u.pn * 256 + wc * 32 + 8 * fq;
                if (r < u.nvalid) {
#pragma unroll
                    for (int bj = 0; bj < 2; ++bj) {
                        const f32x4 v0 = acc[ai][bj][m][0] * w, v1 = acc[ai][bj][m][1] * w;
                        *(u32x2*)(dst + bj * 128) = (u32x2){pk4_fp8(v0[0], v0[1], v0[2], v0[3]), pk4_fp8(v1[0], v1[1], v1[2], v1[3])};
                    }
                }
            }
    }
};
template <int WHICH>
__device__ __forceinline__ void phase_moe(const Params& p, LAS unsigned char* lds, int tid, int G, int bid) {
    unsigned char* ws = p.ws;
    const int* gtot = (const int*)(ws + RT_TOT); const int* row_asg = (const int*)(ws + RT_ROW);
    LAS int* ltot = (LAS int*)(lds + 131072); LAS int* lpst = ltot + 32; LAS int* lcum = ltot + 64;
    __syncthreads();
    if (tid < 32) { ltot[tid] = gtot[tid]; lpst[tid] = gtot[32 + tid]; }
    __syncthreads();
    if (tid == 0) { int c = 0; for (int e = 0; e < 32; ++e) { lcum[e] = c; c += ((ltot[e] + 255) >> 8) * 4; } lcum[32] = c; }
    __syncthreads();
    const int NU = __builtin_amdgcn_readfirstlane(lcum[32]);
    if (WHICH == 0) {
        MoeOrder<true> S{(const unsigned char*)(ws + WS_U8), (const unsigned char*)p.out, D, (size_t)1024 * 1024, row_asg, ltot, lpst, lcum, NU, G, bid};
        EpiGU2 E{(unsigned char*)(ws + WS_HID), (const float*)(ws + RT_ROWRS)};
        pg8::gemm_phase<EpiGU2, MoeOrder<true>, true>(lds, S, E);
    } else {
        MoeOrder<false> S{(const unsigned char*)(ws + WS_HID), (const unsigned char*)p.out + (size_t)NE * 1024 * 1024, DE, (size_t)1024 * 512, row_asg, ltot, lpst, lcum, NU, G, bid};
        EpiDown2 E{ws + WS_YM0, row_asg, (const float*)(ws + RT_ROWW)};
        pg8::gemm_phase<EpiDown2, MoeOrder<false>, true>(lds, S, E);
    }
}

__device__ __forceinline__ void phase_final(const Params& p, int lane, int wid, int G, int bid) {
    unsigned char* ws = p.ws;
    const bf16_t* hmid = (const bf16_t*)(ws + WS_HMID); const unsigned char* y0 = ws + WS_YM0; const unsigned char* y1 = ws + WS_YM1;
    const float* gfin = p.in[25]; float* out = p.out;
    for (int m2 = bid * 8 + wid; m2 < M2; m2 += G * 8) {
        f32x4 v[4]; float s = 0.f;
#pragma unroll
        for (int j = 0; j < 4; ++j) {
            const size_t o = (size_t)m2 * D + 4 * lane + 256 * j;
            const u32x2 hw = *(const u32x2*)(hmid + o); f32x4 hv = (f32x4){bflo(hw.x), bfhi(hw.x), bflo(hw.y), bfhi(hw.y)};
            const unsigned a = *(const unsigned*)(y0 + o), b = *(const unsigned*)(y1 + o);
            hv.x += __builtin_amdgcn_cvt_f32_fp8(a, 0) + __builtin_amdgcn_cvt_f32_fp8(b, 0); hv.y += __builtin_amdgcn_cvt_f32_fp8(a, 1) + __builtin_amdgcn_cvt_f32_fp8(b, 1);
            hv.z += __builtin_amdgcn_cvt_f32_fp8(a, 2) + __builtin_amdgcn_cvt_f32_fp8(b, 2); hv.w += __builtin_amdgcn_cvt_f32_fp8(a, 3) + __builtin_amdgcn_cvt_f32_fp8(b, 3);
            v[j] = hv; s += (hv.x * hv.x + hv.y * hv.y) + (hv.z * hv.z + hv.w * hv.w);
        }
        s = wave_sum(s);
        const float rs = 1.f / sqrtf(s * (1.f / D) + 1e-6f);
#pragma unroll
        for (int j = 0; j < 4; ++j) {
            const f32x4 g = *(const f32x4*)(gfin + 4 * lane + 256 * j);
            *(f32x4*)(out + (size_t)m2 * D + 4 * lane + 256 * j) = v[j] * rs * g;
        }
    }
}

__global__ void __launch_bounds__(512, 2) fwd(Params p) {
    extern __shared__ __attribute__((aligned(16))) unsigned char lds_raw[];
    LAS unsigned char* lds = (LAS unsigned char*)lds_raw;
    const int G = gridDim.x, bid = blockIdx.x;
    volatile LAS unsigned* xbw = (volatile LAS unsigned*)(lds + LDS_XB);
    if (threadIdx.x < 4) xbw[threadIdx.x] = 0u;
    __syncthreads();
    const int lo = p.ph_lo, hi = p.ph_hi;
    unsigned* barw = (unsigned*)(p.ws + WS_CTL) + CW_BAR;
    XcdBarrier bar; bar.bar = barw; bar.x = 0; bar.st = xbw;
    if (hi - lo > 1) bar = xcd_barrier_post(barw, xbw);
#define IN(k) (lo <= (k) && (k) < hi)
#define SEAM(k) do { if (IN(k) && IN((k) + 1)) xcd_barrier(bar); } while (0)
#define REP(k) int nrep_##k = ((PROBE_REP == (k)) ? 2 : 1); if (PROBE_REP == (k)) asm volatile("" : "+s"(nrep_##k)); for (int rep_ = 0; rep_ < nrep_##k; ++rep_)
#define FRESH() int tid = threadIdx.x; asm volatile("" : "+v"(tid)); const int lane = tid & 63, wid = __builtin_amdgcn_readfirstlane(tid >> 6); (void)lane; (void)wid;
    if (IN(0)) { FRESH(); REP(0) { phase0(p, lds, tid, lane, wid, G, bid); __syncthreads(); } } SEAM(0);
    if (IN(1)) { FRESH(); REP(1) phase1(p, lds, tid, G, bid); if (bid == G - 1) phase_rwkv_pre<true>(p, lds, tid, lane, wid, G, bid); } SEAM(1);
    if (IN(2)) { FRESH(); REP(2) phase_rwkv_pre<false>(p, lds, tid, lane, wid, G, bid); } SEAM(2);
    if (IN(3)) { FRESH(); REP(30) phase_rwkv_seq(p, lds, lane, wid, G, bid); REP(31) phase_ret(p, lds, tid, lane, wid, G, bid); } SEAM(3);
    if (IN(4)) { FRESH(); REP(4) phase_post(p, lane, wid, G, bid); } SEAM(4);
    if (IN(5)) { FRESH(); REP(5) { phase5(p, lds, tid, lane, wid, G, bid); __syncthreads(); } } SEAM(5);
    if (IN(6)) { FRESH(); REP(6) phase6(p, lds, tid, lane, wid, G, bid); } SEAM(6);
    if (IN(7)) { FRESH(); REP(7) phase7(p, lds, tid, G, bid); } SEAM(7);
    if (IN(8)) { FRESH(); REP(8) phase_moe<0>(p, lds, tid, G, bid); } SEAM(8);
    if (IN(9)) { FRESH(); REP(9) phase_moe<1>(p, lds, tid, G, bid); } SEAM(9);
    if (IN(10)) { FRESH(); REP(10) phase_final(p, lane, wid, G, bid); }
#undef FRESH
#undef REP
#undef IN
#undef SEAM
}

#ifndef N_LAUNCH_MODE
#define N_LAUNCH_MODE 1
#endif
extern "C" void kernel_launch(void* const* d_in, const int* in_sizes, int n_in, void* d_out, int out_size, void* d_ws, size_t ws_size, hipStream_t stream) {
    static int grid = 0;
    if (grid == 0) {
        if (n_in != 26 || out_size != M2 * D || ws_size < WS_END) { fprintf(stderr, "kernel_launch: unexpected shapes (n_in %d out %d ws %zu)\n", n_in, out_size, ws_size); grid = -1; return; }
        int dev = 0, cus = 0;
        if (hipGetDevice(&dev) != hipSuccess || hipDeviceGetAttribute(&cus, hipDeviceAttributeMultiprocessorCount, dev) != hipSuccess) { grid = -1; return; }
        if (hipFuncSetAttribute((const void*)fwd, hipFuncAttributeMaxDynamicSharedMemorySize, LDS_BYTES) != hipSuccess) { grid = -1; return; }
        grid = cus;
    }
    if (grid < 0) return;
    (void)hipMemsetAsync((char*)d_ws + WS_CTL, 0, CTL_ZERO_BYTES, stream);
    Params a{};
    for (int i = 0; i < 26; ++i) a.in[i] = (const float*)d_in[i];
    a.out = (float*)d_out; a.ws = (unsigned char*)d_ws;
#if N_LAUNCH_MODE == 1
    a.ph_lo = 0; a.ph_hi = NPHASE;
    hipLaunchKernelGGL(fwd, dim3(grid), dim3(512), LDS_BYTES, stream, a);
#else
    for (int ph = 0; ph < NPHASE; ++ph) { a.ph_lo = ph; a.ph_hi = ph + 1; hipLaunchKernelGGL(fwd, dim3(grid), dim3(512), LDS_BYTES, stream, a); }
#endif
}
```

```cpp
#include <hip/hip_runtime.h>
#include <cstdio>
#include <cstdint>

#define LAS __attribute__((address_space(3)))
#define GAS __attribute__((address_space(1)))
typedef unsigned short bf16_t;
typedef short bf16x8 __attribute__((ext_vector_type(8)));
typedef float f32x4 __attribute__((ext_vector_type(4)));
typedef unsigned u32x4 __attribute__((ext_vector_type(4)));
typedef unsigned u32x2 __attribute__((ext_vector_type(2)));

constexpr int D = 1024, NBATCH = 16, SEQ = 2048, NMETA = 16, L = SEQ + NMETA, M1 = NBATCH * L, M2 = NBATCH * SEQ;
constexpr int PA = 1792, PB = 2048, PIN = PA + PB;
constexpr int NE = 32, DE = 512, NASG = 2 * M2, NROWS_PAD = 73728;
constexpr int GI = 128;
constexpr int NPHASE = 11;

constexpr size_t MiB = 1u << 20, KiB = 1u << 10;
constexpr size_t WS_CTL = 0, CTL_ZERO_BYTES = 65536;
constexpr size_t WS_WIN = 1 * MiB;
constexpr size_t WS_WOUT = 9 * MiB;
constexpr size_t WS_LORA = 11 * MiB;
constexpr size_t WS_WR = 11 * MiB + 512 * KiB;
constexpr size_t WS_ROPE = 12 * MiB;
constexpr size_t ROPE_HALF = (size_t)L * 64 * 4;
constexpr size_t WS_RSTD1 = 13 * MiB + 256 * KiB;
constexpr size_t WS_SLOT0 = 14 * MiB + 320 * KiB;
constexpr size_t WS_CH = 13 * MiB + 512 * KiB;
constexpr size_t RT_ROWW = 13 * MiB + 512 * KiB, RT_ROWRS = 14 * MiB;
constexpr size_t WS_ROUTE = 14 * MiB + 768 * KiB;
constexpr size_t RT_E = WS_ROUTE, RT_W = WS_ROUTE + 256 * KiB, RT_POS = WS_ROUTE + 512 * KiB, RT_ROW = WS_ROUTE + 768 * KiB,
                 RT_RSTD2 = WS_ROUTE + 1088 * KiB, RT_CNT = WS_ROUTE + 1216 * KiB, RT_TOT = WS_ROUTE + 1248 * KiB;
constexpr size_t WS_ZA = 16 * MiB;
constexpr size_t WS_ZB = 130 * MiB;
constexpr size_t WS_HB = 260 * MiB;
constexpr size_t PS = (size_t)M1 * 512 * 2;
constexpr size_t WS_P = 326 * MiB;
constexpr size_t WS_PR = WS_HB, WS_PK = WS_HB + PS, WS_PW = WS_P, WS_PKK = WS_P + PS, WS_PB = WS_P + 2 * PS, WS_PV = WS_P + 3 * PS, WS_PG = WS_P + 4 * PS;
constexpr size_t WS_Y = 16 * MiB;
constexpr size_t WS_YB = 81 * MiB;
constexpr size_t WS_MIXED = WS_P;
constexpr size_t WS_HMID = WS_ZB;
constexpr size_t WS_WGU = 16 * MiB;
constexpr size_t WS_WD = 80 * MiB;
constexpr size_t WS_U2 = WS_HMID;
constexpr size_t WS_U8 = WS_HB;
constexpr size_t WS_HID = 392 * MiB;
constexpr size_t WS_YM0 = WS_HB, WS_YM1 = WS_P;
constexpr int NCHUNK = 65, SLOT_BYTES = 22528, SL_G = 0, SL_KT = 8192, SL_WQ = 12288, SL_AQK = 16384, SL_V = 18432;
constexpr size_t WS_SLOT = 260 * MiB;
constexpr size_t WS_G2 = 440 * MiB, WS_CV = 473 * MiB;
constexpr size_t WS_END = 506 * MiB;
static_assert(WS_SLOT + (size_t)NBATCH * 8 * NCHUNK * SLOT_BYTES <= WS_G2 && WS_G2 + PS <= WS_CV && WS_CV + PS <= WS_END, "ws map rwkv");
static_assert(WS_ZA + (size_t)M1 * PA * 2 <= WS_ZB && WS_ZB + (size_t)M1 * PB * 2 <= WS_HB && WS_HB + 2 * PS <= WS_P && WS_P + 5 * PS <= WS_END, "ws map");
static_assert(WS_Y + (size_t)M1 * 512 * 4 <= WS_YB && WS_YB + PS <= WS_ZA + (size_t)M1 * PA * 2, "ws map y");
static_assert(WS_MIXED + (size_t)M2 * 1024 * 2 <= WS_PB && WS_HID >= WS_PB && WS_HID + (size_t)NROWS_PAD * 512 * 2 <= WS_END, "ws map 2");
static_assert(WS_WD + (size_t)32 * 1024 * 512 * 2 <= WS_ZA + (size_t)M1 * PA * 2, "ws map 3");

constexpr int CW_MZ = 6144, MZ_READY = 7 * 8;
constexpr int CW_BAR = 1024;
constexpr int LDS_BYTES = 163840, LDS_XB = LDS_BYTES - 64;

__device__ __forceinline__ unsigned f2bf(float f) { unsigned u = __builtin_bit_cast(unsigned, f); return (u + 0x7fffu + ((u >> 16) & 1u)) >> 16; }
typedef float f32x2_t __attribute__((ext_vector_type(2)));
typedef __bf16 bf16x2_t __attribute__((ext_vector_type(2)));
__device__ __forceinline__ unsigned pk2(float lo, float hi) { f32x2_t v = {lo, hi}; bf16x2_t b = __builtin_convertvector(v, bf16x2_t); return __builtin_bit_cast(unsigned, b); }
__device__ __forceinline__ unsigned pk4_fp8(float a, float b, float c, float d) { int w = 0; w = __builtin_amdgcn_cvt_pk_fp8_f32(a, b, w, false); w = __builtin_amdgcn_cvt_pk_fp8_f32(c, d, w, true); return (unsigned)w; }
__device__ __forceinline__ float bflo(unsigned w) { return __builtin_bit_cast(float, w << 16); }
__device__ __forceinline__ float bfhi(unsigned w) { return __builtin_bit_cast(float, w & 0xffff0000u); }
__device__ __forceinline__ float bf2f(bf16_t b) { return __builtin_bit_cast(float, (unsigned)b << 16); }
__device__ __forceinline__ float sigmoidf_(float x) { return __builtin_amdgcn_rcpf(1.f + __builtin_amdgcn_exp2f(-1.4426950408889634f * x)); }
__device__ __forceinline__ float tanhf_(float x) { return 2.f * sigmoidf_(2.f * x) - 1.f; }
__device__ __forceinline__ float wave_sum(float v) {
#pragma unroll
    for (int o = 1; o < 64; o <<= 1) v += __shfl_xor(v, o);
    return v;
}
__device__ __forceinline__ float row16_sum(float v) {
    v += __builtin_bit_cast(float, __builtin_amdgcn_update_dpp(0, __builtin_bit_cast(int, v), 0xB1, 0xF, 0xF, false));
    v += __builtin_bit_cast(float, __builtin_amdgcn_update_dpp(0, __builtin_bit_cast(int, v), 0x4E, 0xF, 0xF, false));
    v += __builtin_bit_cast(float, __builtin_amdgcn_update_dpp(0, __builtin_bit_cast(int, v), 0x141, 0xF, 0xF, false));
    v += __builtin_bit_cast(float, __builtin_amdgcn_update_dpp(0, __builtin_bit_cast(int, v), 0x140, 0xF, 0xF, false));
    return v;
}
#define LDS_WAIT() asm volatile("s_waitcnt lgkmcnt(0)" ::: "memory")
#define VM_WAIT() asm volatile("s_waitcnt vmcnt(0)" ::: "memory")

#define XB_TMO      128
#define XB_XCNT(j)  (256  + 64 * (j))
#define XB_XSUB(j)  (1280 + 64 * (j))
#define XB_XGEN(j)  (2304 + 64 * (j))
#define XB_TOP      3328
#define XB_TOPGEN   3392
#define XCD_BAR_WORDS 3456
#define XB_SPIN_CAP (1u << 18)
__device__ __forceinline__ unsigned xb_ld(unsigned* p)              { return __hip_atomic_load(p, __ATOMIC_RELAXED, __HIP_MEMORY_SCOPE_AGENT); }
__device__ __forceinline__ unsigned xb_add(unsigned* p, unsigned v) { return __hip_atomic_fetch_add(p, v, __ATOMIC_RELAXED, __HIP_MEMORY_SCOPE_AGENT); }
__device__ __forceinline__ unsigned xb_xcc_id() { return (unsigned)__builtin_amdgcn_s_getreg((3 << 11) | 20) & 0xFu; }
#define XB_SPIN(cond, bar) do { unsigned _sp = 0; while (cond) { __builtin_amdgcn_s_sleep(1); \
    if ((++_sp & 255u) == 0u) { if (xb_ld(&(bar)[XB_TMO])) break; if (_sp > XB_SPIN_CAP) { atomicAdd(&(bar)[XB_TMO], 1u); break; } } } } while (0)
struct XcdBarrier { unsigned* bar; unsigned x; volatile LAS unsigned* st; };
__device__ __forceinline__ XcdBarrier xcd_barrier_post(unsigned* bar, volatile LAS unsigned* st) {
    XcdBarrier b; b.bar = bar; b.x = xb_xcc_id(); b.st = st;
    if (threadIdx.x == 0) (void)xb_add(&bar[XB_XCNT(b.x)], 1u);
    return b;
}
__device__ __forceinline__ void xcd_barrier_complete(unsigned* bar, unsigned x, unsigned& nloc, unsigned& nx) {
    const unsigned G = gridDim.x * gridDim.y * gridDim.z;
    unsigned sum, cnt, mine, sp = 0u;
    for (;;) {
        sum = 0u; cnt = 0u; mine = 0u;
#pragma unroll
        for (unsigned j = 0; j < 16; ++j) { const unsigned c = xb_ld(&bar[XB_XCNT(j)]); sum += c; cnt += (c > 0u) ? 1u : 0u; mine = (j == x) ? c : mine; }
        if (sum == G) break;
        __builtin_amdgcn_s_sleep(1);
        if ((++sp & 255u) == 0u) { if (xb_ld(&bar[XB_TMO])) break; if (sp > XB_SPIN_CAP) { atomicAdd(&bar[XB_TMO], 1u); break; } }
    }
    nloc = mine > 0u ? mine : 1u; nx = cnt > 0u ? cnt : 1u;
}
__device__ __forceinline__ void xcd_barrier(const XcdBarrier& b) {
    asm volatile("s_waitcnt vmcnt(0)" ::: "memory");
    __syncthreads();
    if (threadIdx.x == 0) {
        unsigned* bar = b.bar;
        __builtin_amdgcn_s_waitcnt(0);
        unsigned nloc = b.st[0], nx = b.st[1];
        if (nloc == 0u) { xcd_barrier_complete(bar, b.x, nloc, nx); b.st[0] = nloc; b.st[1] = nx; }
        const unsigned old = xb_add(&bar[XB_XSUB(b.x)], 1u);
        const unsigned gen = old / nloc;
        if (old + 1u == (gen + 1u) * nloc) {
            __builtin_amdgcn_fence(__ATOMIC_RELEASE, "agent");
            asm volatile("s_waitcnt vmcnt(0)" ::: "memory");
            const unsigned og = xb_add(&bar[XB_TOP], 1u);
            const unsigned tg = og / nx;
            if (og + 1u == (tg + 1u) * nx) xb_add(&bar[XB_TOPGEN], 1u);
            else XB_SPIN(xb_ld(&bar[XB_TOPGEN]) == tg, bar);
            __builtin_amdgcn_fence(__ATOMIC_ACQUIRE, "agent");
            xb_add(&bar[XB_XGEN(b.x)], 1u);
            asm volatile("s_waitcnt vmcnt(0)" ::: "memory");
        } else {
            XB_SPIN(xb_ld(&bar[XB_XGEN(b.x)]) == gen, bar);
            __builtin_amdgcn_fence(__ATOMIC_ACQUIRE, "agent");
            asm volatile("s_waitcnt vmcnt(0)" ::: "memory");
        }
    }
    __syncthreads();
}

struct Params { const float* in[26]; float* out; unsigned char* ws; int ph_lo, ph_hi; };

namespace pg8 {
typedef int v8i_t __attribute__((ext_vector_type(8)));
typedef short bf16x16_t __attribute__((ext_vector_type(16)));
constexpr int BM = 256, BK = 64, HALF = 128, HTB = HALF * BK * 2, STAGE_BYTES = 8 * HTB, NXCD = 8, WGM = 8;
__host__ __device__ __forceinline__ int lds_byte(int r, int c) { const int st = (r >> 4) * 2 + (c >> 5), rr = r & 15, cc = c & 31, ob = rr * 64 + cc * 2; return st * 1024 + (ob ^ (((ob >> 9) & 1) << 5)); }
__host__ __device__ __forceinline__ void stage_rc(int b, int& R, int& C) { const int st = b / 1024, sb = b % 1024, swz = sb ^ (((sb >> 9) & 1) << 5); R = (st >> 1) * 16 + swz / 64; C = (st & 1) * 32 + (swz % 64) / 2; }
__host__ __device__ __forceinline__ int perm32(int rho) { const int n = rho >> 4, i = rho & 15; return 8 * (i >> 2) + 4 * n + (i & 3); }

struct DenseOrder {
    static constexpr bool GATHER = false, FP8 = false;
    struct Unit { int pm, pn; };
    const bf16_t* A; const bf16_t* Bt; int K; int nM, nN, nwg, G, c;
    __device__ __forceinline__ void init(const bf16_t* A_, const bf16_t* Bt_, int M, int N, int K_, int G_, int c_) { A = A_; Bt = Bt_; K = K_; nM = M / BM; nN = N / BM; nwg = nM * nN; G = G_; c = c_; }
    __device__ __forceinline__ bool next(int i, Unit& u) const {
        const long Lx = (long)i * G + c; if (Lx >= nwg) return false;
        int wgid = (int)Lx; { const int q = nwg / NXCD, r = nwg % NXCD, xcd = wgid % NXCD, off = wgid / NXCD; wgid = (xcd < r ? xcd * (q + 1) : r * (q + 1) + (xcd - r) * q) + off; }
        const int nig = WGM * nN, gid = wgid / nig, fm = gid * WGM, gsz = (nM - fm) < WGM ? (nM - fm) : WGM;
        u.pm = fm + ((wgid % nig) % gsz); u.pn = (wgid % nig) / gsz; return true;
    }
    __device__ __forceinline__ const char* a_base(const Unit& u) const { return (const char*)A + (size_t)u.pm * BM * K * 2; }
    __device__ __forceinline__ const char* b_base(const Unit& u) const { return (const char*)Bt + (size_t)u.pn * BM * K * 2; }
    __device__ __forceinline__ void a_tok(const Unit&, int, unsigned& w0, unsigned& w1) const { w0 = 0u; w1 = 0u; }
};

template <class Epi, class Sched, bool ALIGN_EPI>
__device__ __forceinline__ void gemm_phase(LAS unsigned char* lds, const Sched& S, const Epi& E) {
    constexpr bool GATHER = Sched::GATHER, FP8 = Sched::FP8;
    int tid = threadIdx.x; asm volatile("" : "+v"(tid));
    const int wid = __builtin_amdgcn_readfirstlane(tid >> 6), lane = tid & 63, wr = wid >> 2, wc = wid & 3, fr = lane & 15, fq = lane >> 4;
    const int K = S.K, KB = FP8 ? K : 2 * K, nt = KB / 128;
    unsigned voffB[2], vA[2];
    LAS u32x4* slot = (LAS u32x4*)(lds + 132096) + tid;
#pragma unroll
    for (int i = 0; i < 2; ++i) { int R, C; stage_rc(tid * 16 + i * 8192, R, C); const int Rb = Epi::PERM ? ((R & ~31) + perm32(R & 31)) : R; voffB[i] = (unsigned)(Rb * KB + C * 2);
                                  vA[i] = GATHER ? (unsigned)C * 2u : (unsigned)(R * KB + C * 2); }
    const size_t kstep = (size_t)(BK * 2);
    const size_t hstep = (size_t)HALF * KB;
    const size_t hsA = GATHER ? (size_t)0 : hstep;
    const unsigned rowB = (unsigned)KB;
    const unsigned ldsw = (unsigned)wid * 1024u;
    const int aoff = FP8 ? lds_byte(wr * 64 + fr, fq * 16) : lds_byte(wr * 64 + fr, fq * 8), boff = FP8 ? lds_byte(wc * 32 + fr, fq * 16) : lds_byte(wc * 32 + fr, fq * 8);
    const int one_scale = 0x7F7F7F7F;
    constexpr int KOFS = FP8 ? 16 : 1024;
#define PG8_SA(b, h) (((b) * 2 + (h)) * HTB)
#define PG8_SB(b, h) ((4 + (b) * 2 + (h)) * HTB)
#define PG8_STAGE(bufoff, gbase, voff) do { _Pragma("unroll") for (int _i = 0; _i < 2; ++_i) \
        __builtin_amdgcn_global_load_lds((const unsigned*)((const char*)(gbase) + (voff)[_i]), (LAS unsigned*)(lds + (bufoff) + ldsw + _i * 8192), 16, 0, 0); } while (0)
#define PG8_OFFS(dst, word) do { if (GATHER) { dst[0] = ((word) & 0xffffu) * rowB + vA[0]; dst[1] = ((word) >> 16) * rowB + vA[1]; } else { dst[0] = vA[0]; dst[1] = vA[1]; } } while (0)
#define PG8_LDA(dst, b, h) do { _Pragma("unroll") for (int m = 0; m < 4; ++m) _Pragma("unroll") for (int k = 0; k < 2; ++k) dst[m][k] = *(const LAS bf16x8*)(lds + PG8_SA(b, h) + aoff + m * 2048 + k * KOFS); } while (0)
#define PG8_LDB(dst, b, h) do { _Pragma("unroll") for (int n = 0; n < 2; ++n) _Pragma("unroll") for (int k = 0; k < 2; ++k) dst[n][k] = *(const LAS bf16x8*)(lds + PG8_SB(b, h) + boff + n * 2048 + k * KOFS); } while (0)
#define PG8_MMA(ai, bj, At, Bt) do { __builtin_amdgcn_s_setprio(1); _Pragma("unroll") for (int m = 0; m < 4; ++m) _Pragma("unroll") for (int n = 0; n < 2; ++n) { \
        if constexpr (FP8) { const u32x4 b0_ = __builtin_bit_cast(u32x4, Bt[n][0]), b1_ = __builtin_bit_cast(u32x4, Bt[n][1]), a0_ = __builtin_bit_cast(u32x4, At[m][0]), a1_ = __builtin_bit_cast(u32x4, At[m][1]); \
            const v8i_t bv_ = (v8i_t){(int)b0_.x, (int)b0_.y, (int)b0_.z, (int)b0_.w, (int)b1_.x, (int)b1_.y, (int)b1_.z, (int)b1_.w}, av_ = (v8i_t){(int)a0_.x, (int)a0_.y, (int)a0_.z, (int)a0_.w, (int)a1_.x, (int)a1_.y, (int)a1_.z, (int)a1_.w}; \
            asm volatile("v_mfma_scale_f32_16x16x128_f8f6f4 %0, %1, %2, %0, %3, %3 op_sel_hi:[0,0,0]" : "+v"(acc[ai][bj][m][n]) : "v"(bv_), "v"(av_), "v"(one_scale)); }   \
        else { _Pragma("unroll") for (int k = 0; k < 2; ++k) acc[ai][bj][m][n] = __builtin_amdgcn_mfma_f32_16x16x32_bf16(Bt[n][k], At[m][k], acc[ai][bj][m][n], 0, 0, 0); } } __builtin_amdgcn_s_setprio(0); } while (0)
#define PG8_WAIT_V(n) asm volatile("s_waitcnt vmcnt(" #n ")" ::: "memory")
#define PG8_WAIT_L(n) asm volatile("s_waitcnt lgkmcnt(" #n ")" ::: "memory")
#define PG8_BAR __builtin_amdgcn_s_barrier()
#define PG8_SCHED __builtin_amdgcn_sched_barrier(0)
    typename Sched::Unit cur, nxt; int ui = 0;
    if (!S.next(0, cur)) return;
    f32x4 acc[2][2][4][2];
#pragma unroll
    for (int a = 0; a < 2; ++a)
#pragma unroll
        for (int b = 0; b < 2; ++b)
#pragma unroll
            for (int m = 0; m < 4; ++m)
#pragma unroll
                for (int n = 0; n < 2; ++n) acc[a][b][m][n] = (f32x4){0.f, 0.f, 0.f, 0.f};
    bf16x8 At[4][2], B0[2][2], B1[2][2];
    const char* cA = S.a_base(cur); const char* cB = S.b_base(cur);
    {
        unsigned w0 = 0u, w1 = 0u, o0[2], o1[2];
        if (GATHER) { S.a_tok(cur, tid, w0, w1); *slot = (u32x4){w0, w1, w0, w1}; }
        PG8_OFFS(o0, w0); PG8_OFFS(o1, w1);
        PG8_STAGE(PG8_SB(0, 0), cB, voffB); PG8_STAGE(PG8_SB(0, 1), cB + hstep, voffB); PG8_STAGE(PG8_SA(0, 0), cA, o0); PG8_STAGE(PG8_SA(0, 1), cA + hsA, o1);
        if (wr == 1) PG8_BAR;
        PG8_WAIT_V(2); PG8_BAR;
        PG8_STAGE(PG8_SB(1, 0), cB + kstep, voffB); PG8_STAGE(PG8_SA(1, 0), cA + kstep, o0); PG8_STAGE(PG8_SB(1, 1), cB + hstep + kstep, voffB);
        PG8_WAIT_V(6); PG8_BAR;
    }
    for (;;) {
        const bool has_next = S.next(ui + 1, nxt);
        const char* nA = has_next ? S.a_base(nxt) : cA; const char* nB = has_next ? S.b_base(nxt) : cB;
        if (GATHER && has_next) { unsigned w0, w1; S.a_tok(nxt, tid, w0, w1); const u32x4 t4 = *slot; *slot = (u32x4){t4.x, t4.y, w0, w1}; }
        for (int t = 0; t < nt; t += 2) {
            const bool last = (t == nt - 2);
            const char* a1 = cA + (size_t)(t + 1) * kstep;
            const char* a2 = last ? nA : cA + (size_t)(t + 2) * kstep; const char* b2 = last ? nB : cB + (size_t)(t + 2) * kstep;
            const char* a3 = a2 + kstep; const char* b3 = b2 + kstep;
            unsigned c1[2], x0[2], x1[2];
            if (GATHER) { const u32x4 t4 = *slot; PG8_OFFS(c1, t4.y); const unsigned wx0 = last ? t4.z : t4.x, wx1 = last ? t4.w : t4.y; PG8_OFFS(x0, wx0); PG8_OFFS(x1, wx1); }
            else { PG8_OFFS(c1, 0u); PG8_OFFS(x0, 0u); PG8_OFFS(x1, 0u); }
            PG8_LDB(B0, 0, 0); PG8_LDB(B1, 0, 1); PG8_SCHED; PG8_LDA(At, 0, 0); PG8_STAGE(PG8_SA(1, 1), a1 + hsA, c1);
            PG8_WAIT_V(8); PG8_WAIT_L(0); PG8_BAR; PG8_MMA(0, 0, At, B0); PG8_MMA(0, 1, At, B1); PG8_BAR; PG8_SCHED;
            PG8_LDA(At, 0, 1); PG8_STAGE(PG8_SB(0, 0), b2, voffB); PG8_STAGE(PG8_SB(0, 1), b2 + hstep, voffB); PG8_STAGE(PG8_SA(0, 0), a2, x0);
            PG8_WAIT_V(8); PG8_WAIT_L(0); PG8_BAR; PG8_MMA(1, 0, At, B0); PG8_MMA(1, 1, At, B1); PG8_BAR; PG8_SCHED;
            PG8_LDB(B0, 1, 0); PG8_LDB(B1, 1, 1); PG8_SCHED; PG8_LDA(At, 1, 0); PG8_STAGE(PG8_SA(0, 1), a2 + hsA, x1);
            PG8_WAIT_V(8); PG8_WAIT_L(0); PG8_BAR; PG8_MMA(0, 0, At, B0); PG8_MMA(0, 1, At, B1); PG8_BAR; PG8_SCHED;
            PG8_LDA(At, 1, 1); PG8_STAGE(PG8_SB(1, 0), b3, voffB); PG8_STAGE(PG8_SB(1, 1), b3 + hstep, voffB); PG8_STAGE(PG8_SA(1, 0), a3, x0);
            PG8_WAIT_V(8); PG8_WAIT_L(0); PG8_BAR; PG8_MMA(1, 0, At, B0); PG8_MMA(1, 1, At, B1); PG8_BAR; PG8_SCHED;
        }
        if constexpr (ALIGN_EPI) { if (wr == 0) PG8_BAR; }
        {
            int tz = tid; asm volatile("" : "+v"(tz)); const int lz = tz & 63, wz = __builtin_amdgcn_readfirstlane(tz >> 6);
            if constexpr (FP8) asm volatile("s_nop 15\n\ts_nop 15" ::: "memory");
            E(acc, cur, wz >> 2, wz & 3, lz & 15, lz >> 4);
        }
        if (!has_next) break;
#pragma unroll
        for (int a = 0; a < 2; ++a)
#pragma unroll
            for (int b = 0; b < 2; ++b)
#pragma unroll
                for (int m = 0; m < 4; ++m)
#pragma unroll
                    for (int n = 0; n < 2; ++n) acc[a][b][m][n] = (f32x4){0.f, 0.f, 0.f, 0.f};
        cur = nxt; cA = nA; cB = nB; ++ui;
        if (GATHER) { const u32x4 t4 = *slot; *slot = (u32x4){t4.z, t4.w, t4.z, t4.w}; }
        if constexpr (ALIGN_EPI) { if (wr == 1) PG8_BAR; }
    }
    PG8_WAIT_V(0);
    if constexpr (!ALIGN_EPI) { if (wr == 0) PG8_BAR; }
    PG8_BAR;
#undef PG8_SA
#undef PG8_SB
#undef PG8_STAGE
#undef PG8_OFFS
#undef PG8_LDA
#undef PG8_LDB
#undef PG8_MMA
#undef PG8_WAIT_V
#undef PG8_WAIT_L
#undef PG8_BAR
#undef PG8_SCHED
}
}


__device__ __forceinline__ void tr_load(const float* W, int N, int item, int lane, f32x4 (&v)[16]) {
    const int nblk = N / 64, kb = item / nblk, nb = item % nblk, k0 = 64 * kb, n0 = 64 * nb;
    const int col4 = (lane & 15) * 4, r4 = lane >> 4;
#pragma unroll
    for (int i = 0; i < 16; ++i) v[i] = *(const f32x4*)(W + (size_t)(k0 + 4 * i + r4) * N + n0 + col4);
}
template <bool PERMK = false, bool F8 = false, class RowMap>
__device__ __forceinline__ void tr_store(f32x4 (&v)[16], int K, int N, bf16_t* WT, const RowMap& rmap, const float* kscale, LAS float* scr, int item, int lane) {
    const int nblk = N / 64, kb = item / nblk, nb = item % nblk, k0 = 64 * kb, n0 = 64 * nb;
    const int col4 = (lane & 15) * 4, r4 = lane >> 4;
#pragma unroll
    for (int i = 0; i < 16; ++i) {
        const int kk = 4 * i + r4;
        if (kscale) v[i] = v[i] * kscale[k0 + kk];
        *(LAS f32x4*)(scr + kk * 64 + (col4 ^ (4 * (kk >> 3)))) = v[i];
    }
    LDS_WAIT(); asm volatile("" ::: "memory");
    const int c = lane & 7;
#pragma unroll
    for (int j = 0; j < 8; ++j) {
        const int n = (lane >> 3) + 8 * j; const LAS float* s = scr + (8 * c) * 64 + (n ^ (4 * c));
        u32x4 o;
        if (PERMK) {
            float f[8];
#pragma unroll
            for (int e = 0; e < 8; ++e) { const int kk = 16 * ((2 * c + (e >> 2)) & 3) + 4 * (c >> 1) + (e & 3); f[e] = scr[kk * 64 + (n ^ (4 * (kk >> 3)))]; }
            o.x = pk2(f[0], f[1]); o.y = pk2(f[2], f[3]); o.z = pk2(f[4], f[5]); o.w = pk2(f[6], f[7]);
        } else if (F8) { *(u32x2*)((unsigned char*)WT + (size_t)rmap(n0 + n) * K + k0 + 8 * c) = (u32x2){pk4_fp8(32.f * s[0 * 64], 32.f * s[1 * 64], 32.f * s[2 * 64], 32.f * s[3 * 64]), pk4_fp8(32.f * s[4 * 64], 32.f * s[5 * 64], 32.f * s[6 * 64], 32.f * s[7 * 64])}; continue;
        } else { o.x = pk2(s[0 * 64], s[1 * 64]); o.y = pk2(s[2 * 64], s[3 * 64]); o.z = pk2(s[4 * 64], s[5 * 64]); o.w = pk2(s[6 * 64], s[7 * 64]); }
        *(u32x4*)(WT + (size_t)rmap(n0 + n) * K + k0 + 8 * c) = o;
    }
    LDS_WAIT(); asm volatile("" ::: "memory");
}
template <bool PERMK = false, class RowMap>
__device__ __forceinline__ void transpose_item(const float* W, int K, int N, bf16_t* WT, const RowMap& rmap, const float* kscale, LAS float* scr, int item, int lane) {
    f32x4 v[16];
    tr_load(W, N, item, lane, v);
    tr_store<PERMK>(v, K, N, WT, rmap, kscale, scr, item, lane);
}
struct MapId { __device__ __forceinline__ int operator()(int n) const { return n; } };
struct MapZ { __device__ __forceinline__ int operator()(int n) const { if (n < PA || n >= PA + 1024) return n; const int o = (n - PA) & 127; return n - o + 2 * (o & 63) + (o >> 6); } };
struct MapGU { int up; __device__ __forceinline__ int operator()(int n) const { return 2 * GI * (n / GI) + GI * up + (n % GI); } };

__device__ __forceinline__ void phase0(const Params& p, LAS unsigned char* lds, int tid, int lane, int wid, int G, int bid) {
    LAS float* scr = (LAS float*)(lds + wid * 16384);
    const int gw = bid * 8 + wid, NGW = G * 8;
    unsigned char* ws = p.ws;
    constexpr int I_IN = 16 * 60, I_OUT = 16 * 16, I_DEC = 8, I_ICL = 8, I_GATE = 16, NIT = I_IN + I_OUT + I_DEC + I_ICL + I_GATE;
    MapId id;
    for (int it = gw; it < NIT; it += NGW) {
        int r = it;
        if (r < I_IN) { MapZ mz; transpose_item(p.in[3], 1024, PIN, (bf16_t*)(ws + WS_WIN), mz, p.in[2], scr, r, lane); continue; } r -= I_IN;
        if (r < I_OUT) { if (r < I_OUT / 2) transpose_item<true>(p.in[16], 1024, 1024, (bf16_t*)(ws + WS_WOUT), id, nullptr, scr, r, lane);
                         else transpose_item(p.in[16], 1024, 1024, (bf16_t*)(ws + WS_WOUT), id, nullptr, scr, r, lane); continue; } r -= I_OUT;
        if (r < I_DEC) { transpose_item(p.in[6], 64, 512, (bf16_t*)(ws + WS_LORA), id, nullptr, scr, r, lane); continue; } r -= I_DEC;
        if (r < I_ICL) { transpose_item(p.in[8], 64, 512, (bf16_t*)(ws + WS_LORA + 64 * KiB), id, nullptr, scr, r, lane); continue; } r -= I_ICL;
        transpose_item(p.in[9], 128, 512, (bf16_t*)(ws + WS_LORA + 128 * KiB), id, nullptr, scr, r, lane);
    }
    {
        bf16_t* Wr = (bf16_t*)(ws + WS_WR); const float* gf = p.in[17]; const float* wrg = p.in[18]; const float* wre = p.in[20];
        for (int i = bid * 512 + tid; i < 36 * 1024; i += G * 512) {
            const int j = i >> 10, k = i & 1023;
            const float v = (j < 4) ? gf[k] * wrg[k * 4 + j] : gf[k] * wre[k * 32 + (j - 4)];
            const unsigned hi = f2bf(v); const float r = v - __builtin_bit_cast(float, hi << 16);
            Wr[i] = (bf16_t)hi; Wr[36 * 1024 + i] = (bf16_t)f2bf(r);
        }
    }
    {
        float* rc = (float*)(ws + WS_ROPE); float* rs = (float*)(ws + WS_ROPE + ROPE_HALF);
        for (int i = bid * 512 + tid; i < L * 64; i += G * 512) {
            const int pos = i >> 6, j = i & 63;
            const double inv = pow(10000.0, -(double)(2 * j) / 128.0); const double ang = (double)pos * inv;
            rc[i] = (float)cos(ang); rs[i] = (float)sin(ang);
        }
    }
    {
        bf16_t* hb = (bf16_t*)(ws + WS_HB); float* rstd = (float*)(ws + WS_RSTD1); const float* x = p.in[0]; const float* meta = p.in[1];
        for (int m = gw; m < M1; m += NGW) {
            const int b = m / L, t = m - b * L;
            const float* src = (t < NMETA) ? meta + (size_t)t * D : x + ((size_t)b * SEQ + (t - NMETA)) * D;
            f32x4 v[4]; float s = 0.f;
#pragma unroll
            for (int j = 0; j < 4; ++j) { v[j] = *(const f32x4*)(src + 4 * lane + 256 * j); s += (v[j].x * v[j].x + v[j].y * v[j].y) + (v[j].z * v[j].z + v[j].w * v[j].w); }
            s = wave_sum(s);
            if (lane == 0) rstd[m] = 1.f / sqrtf(s * (1.f / D) + 1e-6f);
#pragma unroll
            for (int j = 0; j < 4; ++j) { u32x2 o; o.x = pk2(v[j].x, v[j].y); o.y = pk2(v[j].z, v[j].w); *(u32x2*)(hb + (size_t)m * D + 4 * lane + 256 * j) = o; }
        }
    }
}

__device__ __forceinline__ float ret_lg2(int h) { return (h == 0) ? -0.04580368961312479f : (h == 1) ? -0.02272007650008353f : (h == 2) ? -0.011315313227834146f : -0.005646563141142063f; }
struct EpiZ2 {
    static constexpr bool PERM = true;
    bf16_t* zA; bf16_t* zB; const float* rstd; const float* ropeC; const float* ropeS; unsigned* flag;
    __device__ __forceinline__ void operator()(const f32x4 (&acc)[2][2][4][2], const pg8::DenseOrder::Unit& u, int wr, int wc, int fr, int fq) const {
        tile(acc, u, wr, wc, fr, fq);
        if (u.pm == 0 && u.pn < 7) {
            __builtin_amdgcn_fence(__ATOMIC_RELEASE, "agent");
            asm volatile("s_waitcnt vmcnt(0)" ::: "memory");
            if (fr + fq == 0) (void)xb_add(flag, 1u);
        }
    }
    __device__ __forceinline__ void tile(const f32x4 (&acc)[2][2][4][2], const pg8::DenseOrder::Unit& u, int wr, int wc, int fr, int fq) const {
        const int row0 = u.pm * 256 + wr * 64 + fr;
        bf16_t* base = (u.pn < 7) ? zA : zB; const int ld = (u.pn < 7) ? PA : PB; const int colt = (u.pn < 7) ? u.pn * 256 : (u.pn - 7) * 256;
        const int col0 = colt + wc * 32 + 8 * fq;
        const bool rot = (u.pn >= 7) && (u.pn < 11), isq = u.pn < 9;
        const int hd0 = 2 * (u.pn - (isq ? 7 : 9));
#pragma unroll
        for (int ai = 0; ai < 2; ++ai)
#pragma unroll
            for (int m = 0; m < 4; ++m) {
                const int row = row0 + ai * 128 + m * 16; const float rs = rstd[row];
                bf16_t* rowp = base + (size_t)row * ld + col0;
                if (rot) {
                    const int t = row - (row / L) * L; const float ic = (float)((t + 48) & 63);
                    const f32x4 c4 = *(const f32x4*)(ropeC + (size_t)t * 64 + 16 * wc + 4 * fq), s4 = *(const f32x4*)(ropeS + (size_t)t * 64 + 16 * wc + 4 * fq);
#pragma unroll
                    for (int bj = 0; bj < 2; ++bj) {
                        const float e = ic * ret_lg2(hd0 + bj), f = isq ? rs * __builtin_amdgcn_exp2f(e) : rs * 0.08838834764831845f * __builtin_amdgcn_exp2f(-e);
                        float o[8];
#pragma unroll
                        for (int n = 0; n < 2; ++n)
#pragma unroll
                            for (int h2 = 0; h2 < 2; ++h2) {
                                const float t1 = acc[ai][bj][m][n][2 * h2], t2 = acc[ai][bj][m][n][2 * h2 + 1], cc = c4[2 * n + h2], sn = s4[2 * n + h2];
                                o[4 * n + 2 * h2] = (t1 * cc - t2 * sn) * f; o[4 * n + 2 * h2 + 1] = (t1 * sn + t2 * cc) * f;
                            }
                        *(u32x4*)(rowp + bj * 128) = (u32x4){pk2(o[0], o[1]), pk2(o[2], o[3]), pk2(o[4], o[5]), pk2(o[6], o[7])};
                    }
                } else {
#pragma unroll
                    for (int bj = 0; bj < 2; ++bj) {
                        const f32x4 v0 = acc[ai][bj][m][0] * rs, v1 = acc[ai][bj][m][1] * rs;
                        *(u32x4*)(rowp + bj * 128) = (u32x4){pk2(v0[0], v0[1]), pk2(v0[2], v0[3]), pk2(v1[0], v1[1]), pk2(v1[2], v1[3])};
                    }
                }
            }
    }
};
__device__ __forceinline__ void phase1(const Params& p, LAS unsigned char* lds, int tid, int G, int bid) {
    unsigned char* ws = p.ws;
    pg8::DenseOrder S; S.init((const bf16_t*)(ws + WS_HB), (const bf16_t*)(ws + WS_WIN), M1, PIN, D, G, bid);
    EpiZ2 E{(bf16_t*)(ws + WS_ZA), (bf16_t*)(ws + WS_ZB), (const float*)(ws + WS_RSTD1), (const float*)(ws + WS_ROPE), (const float*)(ws + WS_ROPE + ROPE_HALF), (unsigned*)(ws + WS_CTL) + CW_MZ};
    pg8::gemm_phase<EpiZ2, pg8::DenseOrder, true>(lds, S, E);
}

#ifndef PROBE_REP
#define PROBE_REP -1
#endif
#define SUBREP(k) int nsub_##k = ((PROBE_REP == (k)) ? 2 : 1); if (PROBE_REP == (k)) asm volatile("" : "+s"(nsub_##k)); for (int sr_ = 0; sr_ < nsub_##k; ++sr_)
typedef short v4i16_t __attribute__((ext_vector_type(4)));
__device__ __forceinline__ bf16x8 tr8(const LAS unsigned char* p0, const LAS unsigned char* p1) {
    const v4i16_t a = __builtin_amdgcn_ds_read_tr16_b64_v4i16((LAS v4i16_t*)p0), b = __builtin_amdgcn_ds_read_tr16_b64_v4i16((LAS v4i16_t*)p1);
    return (bf16x8){a[0], a[1], a[2], a[3], b[0], b[1], b[2], b[3]};
}
__device__ __forceinline__ bf16x8 packf(const f32x4& a, const f32x4& b) { return __builtin_bit_cast(bf16x8, (u32x4){pk2(a[0], a[1]), pk2(a[2], a[3]), pk2(b[0], b[1]), pk2(b[2], b[3])}); }
#define DPP_SHR(x, n) __builtin_bit_cast(float, __builtin_amdgcn_update_dpp(0, __builtin_bit_cast(int, (x)), 0x110 + (n), 0xF, 0xF, true))
#define MF(a, b, c) __builtin_amdgcn_mfma_f32_16x16x32_bf16((a), (b), (c), 0, 0, 0)
template <bool META>
__device__ __forceinline__ void phase_rwkv_pre(const Params& p, LAS unsigned char* lds, int tid, int lane, int wid, int G, int bid) {
    unsigned char* ws = p.ws;
    const bf16_t* zA = (const bf16_t*)(ws + WS_ZA);
    const float* mu = p.in[4]; const float* w0 = p.in[5]; const float* a0 = p.in[7]; const float* kkp = p.in[10]; const float* kap = p.in[11]; const float* rkp = p.in[12];
    const bf16_t* decT = (const bf16_t*)(ws + WS_LORA); const bf16_t* iclT = (const bf16_t*)(ws + WS_LORA + 64 * KiB); const bf16_t* gatT = (const bf16_t*)(ws + WS_LORA + 128 * KiB);
    bf16_t* Pg = (bf16_t*)(ws + WS_G2); bf16_t* Pcv = (bf16_t*)(ws + WS_CV);
    LAS unsigned char* scr = lds + wid * 18176;
    LAS unsigned char* Al = scr; LAS unsigned char* Bl = scr + 4608; LAS unsigned char* Kl = scr + 9216;
    LAS float* Tm = (LAS float*)(scr + 13824);
    LAS float* gC = (LAS float*)(scr + 17920);
    LAS float* PRM = (LAS float*)(lds + 145408);
    LAS float* MUL = PRM + 8 * 512;
    __syncthreads();
    for (int i = tid; i < 8 * 512; i += 512) { const int q = i >> 9, c = i & 511;
        PRM[i] = (q == 0) ? mu[c] : (q == 1) ? mu[512 + c] : (q == 2) ? mu[1024 + c] : (q == 3) ? w0[c] : (q == 4) ? a0[c] : (q == 5) ? kkp[c] : (q == 6) ? kap[c] : rkp[c]; }
    if (tid < 256) MUL[tid] = mu[1536 + tid];
    __syncthreads();
    if (META && wid != 0) return;
    for (int unit = META ? 0 : bid; unit < (META ? 1 : NBATCH * (NCHUNK - 1) * (PROBE_REP == 20 ? 2 : 1)); unit += G) {
        const int b = META ? 0 : (unit >> 6) & 15, c = META ? 0 : (unit & 63) + 1, t0 = 32 * c - 16;
        int lz = lane, h = META ? bid - (G - 8) : wid; asm volatile("" : "+v"(lz), "+s"(h));
        const int fr = lz & 15, fq = lz >> 4;
        float z0_ = 0.f; asm volatile("" : "+v"(z0_)); const f32x4 Z4 = (f32x4){z0_, z0_, z0_, z0_}; const unsigned zu_ = __builtin_bit_cast(unsigned, z0_); const u32x4 ZU4 = (u32x4){zu_, zu_, zu_, zu_};
        u32x4 cur[2][3][2];
#define CURLOAD(MT) do { const int t_ = t0 + (MT) * 16 + fr; const bf16_t* zc_ = zA + ((size_t)b * L + (t_ >= 0 ? t_ : 0)) * PA + h * 64 + 16 * fq; \
            _Pragma("unroll") for (int q_ = 0; q_ < 3; ++q_) { cur[MT][q_][0] = ZU4; cur[MT][q_][1] = ZU4; if (t_ >= 0) { cur[MT][q_][0] = *(const u32x4*)(zc_ + 512 * q_); cur[MT][q_][1] = *(const u32x4*)(zc_ + 512 * q_ + 8); } } } while (0)
        CURLOAD(0);
        LAS unsigned char* bndl = (LAS unsigned char*)Tm + 256;
        LAS unsigned char* bndlo = bndl + 384;
        if (t0 > 0) { if (lz < 56) __builtin_amdgcn_global_load_lds((const unsigned*)((lz < 24) ? zA + ((size_t)b * L + t0 - 1) * PA + h * 64 + 512 * (lz >> 3) + 8 * (lz & 7) : zA + ((size_t)b * L + t0 - 1) * PA + 1536 + 8 * (lz - 24)), (LAS unsigned*)bndl, 16, 0, 0); }
        else if (lz < 56) *(LAS u32x4*)(bndl + lz * 16) = ZU4;
        if (t0 + 15 >= 0) { if (lz < 32) __builtin_amdgcn_global_load_lds((const unsigned*)(zA + ((size_t)b * L + t0 + 15) * PA + 1536 + 8 * lz), (LAS unsigned*)(bndl + 1024), 16, 0, 0); }
        else if (lz < 32) *(LAS u32x4*)(bndl + 1024 + lz * 16) = ZU4;
        const int wrow = h * 64 + 16 * (fr >> 2) + (fr & 3);
        unsigned char* slotb = META ? ws + WS_SLOT0 + (size_t)h * SLOT_BYTES : ws + WS_SLOT + ((size_t)(b * 8 + h) * NCHUNK + c) * SLOT_BYTES;
        u32x2 R2[2][4];
        u32x4 lc[8];
#define LOC(f) (((f) < 4) ? 128 + (f) * 32 + fq * 8 : ((f) < 6) ? ((f) - 4) * 32 + fq * 8 : 64 + ((f) - 6) * 32 + fq * 8)
        { const int t_ = t0 + fr; const bf16_t* lp_ = zA + ((size_t)b * L + (t_ >= 0 ? t_ : 0)) * PA + 1536;
#pragma unroll
          for (int f_ = 0; f_ < 8; ++f_) { lc[f_] = ZU4; if (t_ >= 0) lc[f_] = *(const u32x4*)(lp_ + LOC(f_)); } }
#undef LOC
        SUBREP(22)
#pragma unroll
        for (int mt = 0; mt < 2; ++mt) {
            const int t = t0 + mt * 16 + fr; const bool valid = t >= 0; const size_t m = (size_t)b * L + (valid ? t : 0);
#define LOC(f) (((f) < 4) ? 128 + (f) * 32 + fq * 8 : ((f) < 6) ? ((f) - 4) * 32 + fq * 8 : 64 + ((f) - 6) * 32 + fq * 8)
#define LOLOAD(MT) do { const int t_ = t0 + (MT) * 16 + fr; const bf16_t* lp_ = zA + ((size_t)b * L + (t_ >= 0 ? t_ : 0)) * PA + 1536; \
                _Pragma("unroll") for (int f_ = 0; f_ < 8; ++f_) { lc[f_] = ZU4; if (t_ >= 0) lc[f_] = *(const u32x4*)(lp_ + LOC(f_)); } } while (0)
#define LOFRAG(dst, f, ACT) do { const f32x4 m0_ = *(const LAS f32x4*)(MUL + LOC(f)), m1_ = *(const LAS f32x4*)(MUL + LOC(f) + 4); unsigned o_[4]; \
                _Pragma("unroll") for (int i_ = 0; i_ < 4; ++i_) { const unsigned cw1_ = lc[f][i_]; const unsigned dp_ = (unsigned)__builtin_amdgcn_update_dpp(0, (int)cw1_, 0x111, 0xF, 0xF, true); const unsigned pv_ = (fr == 0) ? *(const LAS unsigned*)((mt == 0 ? bndlo : bndl + 1024) + LOC(f) * 2 + i_ * 4) : dp_; \
                    float v0_ = bflo(cw1_), v1_ = bfhi(cw1_); v0_ += (bflo(pv_) - v0_) * (i_ < 2 ? m0_[2 * i_] : m1_[2 * i_ - 4]); v1_ += (bfhi(pv_) - v1_) * (i_ < 2 ? m0_[2 * i_ + 1] : m1_[2 * i_ - 3]); \
                    if (ACT == 1) { v0_ = tanhf_(v0_); v1_ = tanhf_(v1_); } else if (ACT == 2) { v0_ = sigmoidf_(v0_); v1_ = sigmoidf_(v1_); } o_[i_] = pk2(v0_, v1_); } \
                dst = __builtin_bit_cast(bf16x8, (u32x4){o_[0], o_[1], o_[2], o_[3]}); } while (0)
            if (mt == 0) VM_WAIT();
            bf16x8 xw[2], xa[2];
            SUBREP(21) {
                bf16x8 xg[4];
#pragma unroll
                for (int ks = 0; ks < 4; ++ks) LOFRAG(xg[ks], ks, 2);
                f32x4 dg[4];
#pragma unroll
                for (int nt = 0; nt < 4; ++nt) { dg[nt] = Z4;
#pragma unroll
                    for (int ks = 0; ks < 4; ++ks) dg[nt] = MF(*(const bf16x8*)(gatT + (size_t)(wrow + 4 * nt) * 128 + ks * 32 + fq * 8), xg[ks], dg[nt]); }
                if (valid && !META) {
                    bf16_t* gp = Pg + m * 512 + h * 64 + 4 * fq;
#pragma unroll
                    for (int nt = 0; nt < 4; ++nt) *(u32x2*)(gp + 16 * nt) = (u32x2){pk2(dg[nt][0], dg[nt][1]), pk2(dg[nt][2], dg[nt][3])};
                }
            }
#pragma unroll
            for (int ks = 0; ks < 2; ++ks) { LOFRAG(xw[ks], 4 + ks, 1); LOFRAG(xa[ks], 6 + ks, 0); }
            __builtin_amdgcn_sched_barrier(0);
            f32x4 dw[4], da[4];
#pragma unroll
            for (int nt = 0; nt < 4; ++nt) { dw[nt] = Z4; da[nt] = Z4;
#pragma unroll
                for (int ks = 0; ks < 2; ++ks) {
                    dw[nt] = MF(*(const bf16x8*)(decT + (size_t)(wrow + 4 * nt) * 64 + ks * 32 + fq * 8), xw[ks], dw[nt]);
                    da[nt] = MF(*(const bf16x8*)(iclT + (size_t)(wrow + 4 * nt) * 64 + ks * 32 + fq * 8), xa[ks], da[nt]); } }
#undef LOFRAG
            __builtin_amdgcn_sched_barrier(0);
            const int colb = h * 64 + 16 * fq;
#define PREVW(q, w) ({ const unsigned cw_ = cur[mt][q][(w) >> 2][(w) & 3]; unsigned pw_ = (unsigned)__builtin_amdgcn_update_dpp(0, (int)cw_, 0x111, 0xF, 0xF, true); \
                       const unsigned ew_ = (mt == 0) ? *(const LAS unsigned*)(bndl + (q) * 128 + fq * 32 + (w) * 4) : (unsigned)__shfl((int)cur[0][q][(w) >> 2][(w) & 3], lz | 15); (fr == 0) ? ew_ : pw_; })
#define PRMV(q, nt) (*(const LAS f32x4*)(PRM + (q) * 512 + colb + 4 * (nt)))
            float ss = 0.f, cs = 0.f; unsigned cvw[8];
#pragma unroll
            for (int nt = 0; nt < 4; ++nt) {
                const unsigned c0 = cur[mt][1][(2 * nt) >> 2][(2 * nt) & 3], c1 = cur[mt][1][(2 * nt + 1) >> 2][(2 * nt + 1) & 3], p0 = PREVW(1, 2 * nt), p1 = PREVW(1, 2 * nt + 1);
                const f32x4 muk = PRMV(1, nt), kkv = PRMV(5, nt);
                const f32x4 kcv = (f32x4){bflo(c0), bfhi(c0), bflo(c1), bfhi(c1)}, kpv = (f32x4){bflo(p0), bfhi(p0), bflo(p1), bfhi(p1)};
                const f32x4 kz = kcv + (kpv - kcv) * muk;
                const f32x4 kq = kz * kkv; ss += (kq[0] * kq[0] + kq[1] * kq[1]) + (kq[2] * kq[2] + kq[3] * kq[3]);
            }
            ss += __shfl_xor(ss, 16); ss += __shfl_xor(ss, 32);
            const float inv = 1.f / fmaxf(sqrtf(ss), 1e-12f);
#pragma unroll
            for (int nt = 0; nt < 4; ++nt) {
                const unsigned rc0 = cur[mt][0][(2 * nt) >> 2][(2 * nt) & 3], rc1 = cur[mt][0][(2 * nt + 1) >> 2][(2 * nt + 1) & 3], rp0 = PREVW(0, 2 * nt), rp1 = PREVW(0, 2 * nt + 1);
                const unsigned vc0 = cur[mt][2][(2 * nt) >> 2][(2 * nt) & 3], vc1 = cur[mt][2][(2 * nt + 1) >> 2][(2 * nt + 1) & 3], vp0 = PREVW(2, 2 * nt), vp1 = PREVW(2, 2 * nt + 1);
                const unsigned kc0 = cur[mt][1][(2 * nt) >> 2][(2 * nt) & 3], kc1 = cur[mt][1][(2 * nt + 1) >> 2][(2 * nt + 1) & 3], kp0 = PREVW(1, 2 * nt), kp1 = PREVW(1, 2 * nt + 1);
                const f32x4 kcv = (f32x4){bflo(kc0), bfhi(kc0), bflo(kc1), bfhi(kc1)}, kpv = (f32x4){bflo(kp0), bfhi(kp0), bflo(kp1), bfhi(kp1)};
                const f32x4 kz = kcv + (kpv - kcv) * PRMV(1, nt);
                const f32x4 mur = PRMV(0, nt), muv = PRMV(2, nt), w0v = PRMV(3, nt), a0v = PRMV(4, nt), kkv = PRMV(5, nt), kav = PRMV(6, nt), rkv = PRMV(7, nt);
                const f32x4 rcv = (f32x4){bflo(rc0), bfhi(rc0), bflo(rc1), bfhi(rc1)}, rpv = (f32x4){bflo(rp0), bfhi(rp0), bflo(rp1), bfhi(rp1)};
                const f32x4 vcv = (f32x4){bflo(vc0), bfhi(vc0), bflo(vc1), bfhi(vc1)}, vpv = (f32x4){bflo(vp0), bfhi(vp0), bflo(vp1), bfhi(vp1)};
                const f32x4 r4 = rcv + (rpv - rcv) * mur, v4 = vcv + (vpv - vcv) * muv;
                f32x4 Rh, Ah, Bh, Kh;
#pragma unroll
                for (int j = 0; j < 4; ++j) {
                    const float a = sigmoidf_(a0v[j] + da[nt][j]);
                    const float lw = valid ? -0.8750387749145276f * sigmoidf_(w0v[j] + dw[nt][j]) : 0.f;
                    const float kk = kz[j] * kkv[j] * inv, kn = kz[j] * (1.f + (a - 1.f) * kav[j]);
                    cs += r4[j] * kn * rkv[j];
                    float x = lw;
                    x += DPP_SHR(x, 1); x += DPP_SHR(x, 2); x += DPP_SHR(x, 4); x += DPP_SHR(x, 8);
                    if (mt == 1) x += Tm[nt * 16 + fq * 4 + j];
                    const float ep = __builtin_amdgcn_exp2f(x), em = __builtin_amdgcn_rcpf(ep), epv = __builtin_amdgcn_exp2f(x - lw);
                    Rh[j] = r4[j] * ep; Ah[j] = -kk * epv; Bh[j] = kk * a * em; Kh[j] = kn * em;
                    if (fr == 15) { if (mt == 0) Tm[nt * 16 + fq * 4 + j] = x; else gC[nt * 16 + fq * 4 + j] = ep; }
                }
                R2[mt][nt] = (u32x2){pk2(Rh[0], Rh[1]), pk2(Rh[2], Rh[3])};
                const u32x2 vw = (u32x2){pk2(v4[0], v4[1]), pk2(v4[2], v4[3])};
                *(u32x2*)(slotb + SL_V + nt * 1024 + (mt * 16 + fr) * 32 + fq * 8) = vw;
                cvw[2 * nt] = vw.x; cvw[2 * nt + 1] = vw.y;
                const int off = (mt * 16 + fr) * 144 + (nt * 16 + fq * 4) * 2;
                *(LAS u32x2*)(Al + off) = (u32x2){pk2(Ah[0], Ah[1]), pk2(Ah[2], Ah[3])}; *(LAS u32x2*)(Bl + off) = (u32x2){pk2(Bh[0], Bh[1]), pk2(Bh[2], Bh[3])};
                *(LAS u32x2*)(Kl + off) = (u32x2){pk2(Kh[0], Kh[1]), pk2(Kh[2], Kh[3])};
                __builtin_amdgcn_sched_barrier(0);
            }
#undef PREVW
#undef PRMV
            if (mt == 0) { CURLOAD(1); LOLOAD(1); }
            cs += __shfl_xor(cs, 16); cs += __shfl_xor(cs, 32);
            if (valid && !META) {
                unsigned cw[8];
#pragma unroll
                for (int q = 0; q < 8; ++q) cw[q] = pk2(cs * bflo(cvw[q]), cs * bfhi(cvw[q]));
                bf16_t* cp = Pcv + m * 512 + h * 64 + 4 * fq;
#pragma unroll
                for (int nt = 0; nt < 4; ++nt) *(u32x2*)(cp + 16 * nt) = (u32x2){cw[2 * nt], cw[2 * nt + 1]};
            }
        }
#undef LOLOAD
#undef LOC
#undef CURLOAD
#define FRG(X2, mt, ks) __builtin_bit_cast(bf16x8, (u32x4){X2[mt][2 * (ks)].x, X2[mt][2 * (ks)].y, X2[mt][2 * (ks) + 1].x, X2[mt][2 * (ks) + 1].y})
#define Rf(mt, ks) FRG(R2, mt, ks)
#define FRL(XL, mt, ks) ({ const LAS unsigned char* p_ = (XL) + ((mt) * 16 + fr) * 144 + (32 * (ks) + 4 * fq) * 2; const u32x2 a_ = *(const LAS u32x2*)p_, b_ = *(const LAS u32x2*)(p_ + 32); __builtin_bit_cast(bf16x8, (u32x4){a_.x, a_.y, b_.x, b_.y}); })
#define Af(mt, ks) FRL(Al, mt, ks)
#define Bf(mt, ks) FRL(Bl, mt, ks)
#define Kf(mt, ks) FRL(Kl, mt, ks)
        __builtin_amdgcn_sched_barrier(0);
        const int ri = 4 * fq, cj = fr;
        f32x4 Mak00, Mak10, Mak11, Mrb00, Mrb01, Mrb11, Mrk00, Mrk01, Mrk11;
        {
            f32x4 m00 = MF(Af(0, 0), Bf(0, 0), Z4); m00 = MF(Af(0, 1), Bf(0, 1), m00);
            f32x4 m10 = MF(Af(1, 0), Bf(0, 0), Z4); m10 = MF(Af(1, 1), Bf(0, 1), m10);
            f32x4 m11 = MF(Af(1, 0), Bf(1, 0), Z4); m11 = MF(Af(1, 1), Bf(1, 1), m11);
#pragma unroll
            for (int rg = 0; rg < 4; ++rg) {
                const bool lo = (ri + rg) > cj;
                Tm[(ri + rg) * 32 + cj] = lo ? m00[rg] : 0.f; Tm[(16 + ri + rg) * 32 + cj] = m10[rg]; Tm[(16 + ri + rg) * 32 + 16 + cj] = lo ? m11[rg] : 0.f;
                Tm[(ri + rg) * 32 + 16 + cj] = 0.f;
            }
            Mak00 = MF(Af(0, 0), Kf(0, 0), Z4); Mak00 = MF(Af(0, 1), Kf(0, 1), Mak00);
            Mak10 = MF(Af(1, 0), Kf(0, 0), Z4); Mak10 = MF(Af(1, 1), Kf(0, 1), Mak10);
            Mak11 = MF(Af(1, 0), Kf(1, 0), Z4); Mak11 = MF(Af(1, 1), Kf(1, 1), Mak11);
            Mrb00 = MF(Bf(0, 0), Rf(0, 0), Z4); Mrb00 = MF(Bf(0, 1), Rf(0, 1), Mrb00);
            Mrb01 = MF(Bf(0, 0), Rf(1, 0), Z4); Mrb01 = MF(Bf(0, 1), Rf(1, 1), Mrb01);
            Mrb11 = MF(Bf(1, 0), Rf(1, 0), Z4); Mrb11 = MF(Bf(1, 1), Rf(1, 1), Mrb11);
            Mrk00 = MF(Kf(0, 0), Rf(0, 0), Z4); Mrk00 = MF(Kf(0, 1), Rf(0, 1), Mrk00);
            Mrk01 = MF(Kf(0, 0), Rf(1, 0), Z4); Mrk01 = MF(Kf(0, 1), Rf(1, 1), Mrk01);
            Mrk11 = MF(Kf(1, 0), Rf(1, 0), Z4); Mrk11 = MF(Kf(1, 1), Rf(1, 1), Mrk11);
#pragma unroll
            for (int rg = 0; rg < 4; ++rg) {
                const bool lo = (ri + rg) > cj, up = cj >= (ri + rg);
                Mak00[rg] = lo ? Mak00[rg] : 0.f; Mak11[rg] = lo ? Mak11[rg] : 0.f;
                Mrb00[rg] = up ? Mrb00[rg] : 0.f; Mrb11[rg] = up ? Mrb11[rg] : 0.f; Mrk00[rg] = up ? Mrk00[rg] : 0.f; Mrk11[rg] = up ? Mrk11[rg] : 0.f;
            }
        }
        __builtin_amdgcn_sched_barrier(0);
        {
            const int cc = lz & 31; float tt[32];
#pragma unroll
            for (int i = 0; i < 32; ++i) tt[i] = 0.f;
            LDS_WAIT(); asm volatile("" ::: "memory");
#pragma unroll
            for (int i = 0; i < 32; ++i) {
                float acc = (cc == i) ? 1.f : 0.f;
#pragma unroll
                for (int j4 = 0; j4 < (i + 3) / 4; ++j4) { const f32x4 mm = *(const LAS f32x4*)(Tm + i * 32 + 4 * j4); acc += (mm.x * tt[4 * j4] + mm.y * tt[4 * j4 + 1]) + (mm.z * tt[4 * j4 + 2] + mm.w * tt[4 * j4 + 3]); }
                tt[i] = acc;
                Tm[i * 32 + cc] = acc;
            }
            LDS_WAIT(); asm volatile("" ::: "memory");
        }
        __builtin_amdgcn_sched_barrier(0);
        bf16x8 Atf[4];
        {
            bf16x8 Tn[2];
#pragma unroll
            for (int ti = 0; ti < 2; ++ti) { const LAS float* tp = Tm + (16 * ti + fr) * 32 + 8 * fq; const f32x4 ta = *(const LAS f32x4*)tp, tb = *(const LAS f32x4*)(tp + 4); Tn[ti] = packf(ta, tb); }
#pragma unroll
            for (int kt = 0; kt < 4; ++kt) {
                const LAS unsigned char* ap = Al + (8 * fq + (fr >> 2)) * 144 + (16 * kt + 4 * (fr & 3)) * 2;
                const bf16x8 atr = tr8(ap, ap + 4 * 144);
                Atf[kt] = packf(MF(Tn[0], atr, Z4), MF(Tn[1], atr, Z4));
            }
        }
        bf16x8 TMf[2], MrbTf[2];
        {
            bf16x8 Tp[2];
#pragma unroll
            for (int ti = 0; ti < 2; ++ti) { const LAS float* tp = Tm + (16 * ti + fr) * 32 + 4 * fq; const f32x4 ta = *(const LAS f32x4*)tp, tb = *(const LAS f32x4*)(tp + 16); Tp[ti] = packf(ta, tb); }
            const bf16x8 MakB0 = packf(Mak00, Mak10), MakB1 = packf(Z4, Mak11);
            const f32x4 TM00 = MF(Tp[0], MakB0, Z4), TM10 = MF(Tp[1], MakB0, Z4), TM11 = MF(Tp[1], MakB1, Z4);
            TMf[0] = packf(TM00, TM10); TMf[1] = packf(Z4, TM11);
            MrbTf[0] = packf(Mrb00, Z4); MrbTf[1] = packf(Mrb01, Mrb11);
        }
        unsigned char* slot = slotb + lz * 16;
        __builtin_amdgcn_sched_barrier(0);
#pragma unroll
        for (int ti = 0; ti < 2; ++ti)
#pragma unroll
            for (int ks = 0; ks < 2; ++ks) {
                const u32x2 ra = R2[ti][2 * ks], rb = R2[ti][2 * ks + 1];
                const f32x4 w0t = MF(Atf[2 * ks], MrbTf[ti], ((f32x4){bflo(ra.x), bfhi(ra.x), bflo(ra.y), bfhi(ra.y)})), w1t = MF(Atf[2 * ks + 1], MrbTf[ti], ((f32x4){bflo(rb.x), bfhi(rb.x), bflo(rb.y), bfhi(rb.y)}));
                *(bf16x8*)(slot + SL_WQ + (ti * 2 + ks) * 1024) = packf(w0t, w1t);
            }
        {
            const f32x4 q00 = MF(TMf[0], MrbTf[0], Mrk00), q01 = MF(TMf[0], MrbTf[1], Mrk01), q11 = MF(TMf[1], MrbTf[1], Mrk11);
            *(bf16x8*)(slot + SL_AQK) = packf(q00, Z4);
            *(bf16x8*)(slot + SL_AQK + 1024) = packf(q01, q11);
        }
        __builtin_amdgcn_sched_barrier(0);
        SUBREP(24) {
            const int dd = fr - 4 * fq; unsigned iw[4];
#pragma unroll
            for (int q = 0; q < 4; ++q) iw[q] = (dd == q) ? 0x3F80u : 0u;
            const unsigned ilo = iw[0] | (iw[1] << 16), ihi = iw[2] | (iw[3] << 16);
            const bf16x8 If0 = __builtin_bit_cast(bf16x8, (u32x4){ilo, ihi, 0u, 0u}), If1 = __builtin_bit_cast(bf16x8, (u32x4){0u, 0u, ilo, ihi});
            LDS_WAIT(); asm volatile("" ::: "memory");
#pragma unroll
            for (int kt = 0; kt < 4; ++kt) {
                const int toff = (4 * fq + (fr >> 2)) * 144 + (16 * kt + 4 * (fr & 3)) * 2;
                const bf16x8 btr = tr8(Bl + toff, Bl + toff + 16 * 144), ktr = tr8(Kl + toff, Kl + toff + 16 * 144);
                const float gc = gC[16 * kt + fr];
                f32x4 g4[4];
#pragma unroll
                for (int k2 = 0; k2 < 4; ++k2) {
                    g4[k2] = MF(Atf[k2], btr, Z4);
#pragma unroll
                    for (int rg = 0; rg < 4; ++rg) g4[k2][rg] = (g4[k2][rg] + ((16 * k2 + ri + rg) == (16 * kt + cj) ? 1.f : 0.f)) * gc;
                }
                *(bf16x8*)(slot + SL_G + (kt * 2 + 0) * 1024) = packf(g4[0], g4[1]);
                *(bf16x8*)(slot + SL_G + (kt * 2 + 1) * 1024) = packf(g4[2], g4[3]);
                f32x4 k0 = MF(TMf[0], btr, Z4), k1 = MF(TMf[1], btr, Z4);
                k0 = MF(If0, ktr, k0); k1 = MF(If1, ktr, k1);
                *(bf16x8*)(slot + SL_KT + kt * 1024) = packf(k0 * gc, k1 * gc);
                __builtin_amdgcn_sched_barrier(0);
            }
        }
    }
}

#undef FRG
#undef FRL
#undef Rf
#undef Af
#undef Bf
#undef Kf

__device__ __forceinline__ void moe_weight_copies(const Params& p, LAS float* scr, int lane, int gw, int NGW) {
    unsigned char* Wgu = (unsigned char*)p.out; unsigned char* Wd = (unsigned char*)p.out + (size_t)NE * 1024 * 1024;
    MapId id;
#define MW_SRC(it, W_, N_, r_) const int e_##it = (it) / 384, q_##it = (it) - e_##it * 384; const float* W_ = (q_##it < 128) ? p.in[22] + (size_t)e_##it * 1024 * 512 : (q_##it < 256) ? p.in[23] + (size_t)e_##it * 1024 * 512 : p.in[24] + (size_t)e_##it * 512 * 1024; \
    const int N_ = (q_##it < 256) ? 512 : 1024, r_ = (q_##it < 128) ? q_##it : (q_##it < 256) ? q_##it - 128 : q_##it - 256
    f32x4 va[16], vb[16];
    int it = gw;
    if (it < NE * 384) { MW_SRC(it, W0, N0, r0); tr_load(W0, N0, r0, lane, va); }
    for (; it < NE * 384; it += 2 * NGW) {
        const int it2 = it + NGW, it3 = it + 2 * NGW;
        if (it2 < NE * 384) { MW_SRC(it2, W1, N1, r1); tr_load(W1, N1, r1, lane, vb); }
        {
            const int e = it / 384, q = it - e * 384;
            if (q < 128) { MapGU mg{0}; tr_store<false, true>(va, 1024, 512, (bf16_t*)(Wgu + (size_t)e * 1024 * 1024), mg, p.in[17], scr, q, lane); }
            else if (q < 256) { MapGU mu{1}; tr_store<false, true>(va, 1024, 512, (bf16_t*)(Wgu + (size_t)e * 1024 * 1024), mu, p.in[17], scr, q - 128, lane); }
            else tr_store<false, true>(va, 512, 1024, (bf16_t*)(Wd + (size_t)e * 1024 * 512), id, nullptr, scr, q - 256, lane);
        }
        if (it2 < NE * 384) {
            if (it3 < NE * 384) { MW_SRC(it3, W2, N2, r2); tr_load(W2, N2, r2, lane, va); }
            const int e = it2 / 384, q = it2 - e * 384;
            if (q < 128) { MapGU mg{0}; tr_store<false, true>(vb, 1024, 512, (bf16_t*)(Wgu + (size_t)e * 1024 * 1024), mg, p.in[17], scr, q, lane); }
            else if (q < 256) { MapGU mu{1}; tr_store<false, true>(vb, 1024, 512, (bf16_t*)(Wgu + (size_t)e * 1024 * 1024), mu, p.in[17], scr, q - 128, lane); }
            else tr_store<false, true>(vb, 512, 1024, (bf16_t*)(Wd + (size_t)e * 1024 * 512), id, nullptr, scr, q - 256, lane);
        }
    }
#undef MW_SRC
}
__device__ __forceinline__ void phase_rwkv_seq(const Params& p, LAS unsigned char* lds, int lane, int wid, int G, int bid) {
    unsigned char* ws = p.ws; float* Y = (float*)(ws + WS_Y);
    const int fr = lane & 15, fq = lane >> 4;
    const f32x4 Z4 = (f32x4){0.f, 0.f, 0.f, 0.f};
    constexpr int RB = 19 * 1024;
    if (wid < 2) {
        LAS unsigned char* ring = lds + wid * (3 * RB);
        for (int tb = bid; tb < 256; tb += G) {
            const int bh = (tb & 7) + 8 * (tb >> 4), vt = 2 * ((tb >> 3) & 1) + wid, b = bh >> 3, h = bh & 7;
            const unsigned char* sl = ws + WS_SLOT + (size_t)bh * NCHUNK * SLOT_BYTES + lane * 16;
            const unsigned char* sl0 = ws + WS_SLOT0 + (size_t)h * SLOT_BYTES + lane * 16;
            f32x4 Zs[4] = {Z4, Z4, Z4, Z4};
#define SEQ_ISSUE(cidx) do { const unsigned char* q_ = (((cidx) == 0) ? sl0 : sl) + (size_t)(cidx) * SLOT_BYTES; LAS unsigned char* d_ = ring + ((cidx) % 3) * RB; \
                _Pragma("unroll") for (int f = 0; f < 18; ++f) __builtin_amdgcn_global_load_lds((const unsigned*)(q_ + f * 1024), (LAS unsigned*)(d_ + f * 1024), 16, 0, 0); \
                __builtin_amdgcn_global_load_lds((const unsigned*)(q_ + SL_V + vt * 1024), (LAS unsigned*)(d_ + 18 * 1024), 16, 0, 0); } while (0)
            SEQ_ISSUE(0); SEQ_ISSUE(1);
            for (int c = 0; c < NCHUNK; ++c) {
                if (c + 2 < NCHUNK) { SEQ_ISSUE(c + 2); asm volatile("s_waitcnt vmcnt(38)" ::: "memory"); }
                else if (c + 1 < NCHUNK) asm volatile("s_waitcnt vmcnt(19)" ::: "memory");
                else asm volatile("s_waitcnt vmcnt(0)" ::: "memory");
                const LAS unsigned char* F = ring + (c % 3) * RB + lane * 16;
#define FR_(f) (*(const LAS bf16x8*)(F + (f) * 1024))
                const LAS unsigned char* vb_ = ring + (c % 3) * RB + 18 * 1024 + (4 * fq + (fr >> 2)) * 32 + (4 * (fr & 3)) * 2;
                const bf16x8 zf0 = packf(Zs[0], Zs[1]), zf1 = packf(Zs[2], Zs[3]), vf = tr8(vb_, vb_ + 16 * 32);
#pragma unroll
                for (int mt = 0; mt < 2; ++mt) {
                    f32x4 y = MF(FR_(12 + mt * 2), zf0, Z4); y = MF(FR_(13 + mt * 2), zf1, y); y = MF(FR_(16 + mt), vf, y);
#pragma unroll
                    for (int rg = 0; rg < 4; ++rg) { const int t = 32 * c - 16 + 16 * mt + 4 * fq + rg;
                        if (t >= 0) Y[((size_t)b * L + t) * 512 + h * 64 + 16 * vt + fr] = y[rg]; }
                }
#pragma unroll
                for (int kt = 0; kt < 4; ++kt) { f32x4 zn = MF(FR_(kt * 2), zf0, Z4); zn = MF(FR_(kt * 2 + 1), zf1, zn); zn = MF(FR_(8 + kt), vf, zn); Zs[kt] = zn; }
#undef FR_
            }
#undef SEQ_ISSUE
        }
    } else if (wid < 4) {
        moe_weight_copies(p, (LAS float*)(lds + 2 * 3 * RB + (wid - 2) * 16384), lane, bid * 2 + (wid - 2), G * 2);
    }
}
#undef DPP_SHR
#undef MF

__device__ __forceinline__ void phase_ret(const Params& p, LAS unsigned char* lds, int tid, int lane, int wid, int G, int bid) {
    unsigned char* ws = p.ws; const unsigned char* zB = ws + WS_ZB; bf16_t* Yb = (bf16_t*)(ws + WS_YB);
    bf16_t* sink = (bf16_t*)(ws + WS_CTL + 32768);
    constexpr int RBUF = 36864, QOFF = 0, KOFF = 16384, VOFF = 32768, NRB = 4, DUMMY = NRB * RBUF;
    const int fr = lane & 15, fq = lane >> 4, mt = wid >> 1, nt = wid & 1;
    const f32x4 Z4 = (f32x4){0.f, 0.f, 0.f, 0.f};
    for (int job = bid; job < 256; job += G) {
        const int bh = (job & 7) + 8 * (job >> 5), dvb = (job >> 3) & 3, b = bh >> 2, h = bh & 3;
        const float lg2 = ret_lg2(h), g1 = __builtin_amdgcn_exp2f(lg2), g63 = __builtin_amdgcn_exp2f(63.f * lg2);
        const unsigned char* zrow0 = zB + (size_t)b * L * (PB * 2);
        const int rq0 = 4 * wid + (lane >> 4), rq1 = rq0 + 32, rv = 16 * (wid & 3) + (lane >> 2);
        const unsigned char* pq0 = zrow0 + (ptrdiff_t)(rq0 - 48) * (PB * 2) + h * 256 + (((lane & 15) ^ (rq0 & 15)) << 4);
        const unsigned char* pq1 = zrow0 + (ptrdiff_t)(rq1 - 48) * (PB * 2) + h * 256 + (((lane & 15) ^ (rq1 & 15)) << 4);
        const unsigned char* pv = zrow0 + (ptrdiff_t)(rv - 48) * (PB * 2) + 2048 + h * 256 + dvb * 64 + ((lane & 3) << 4);
        const int dq0 = QOFF + wid * 1024, dq1 = QOFF + (wid + 8) * 1024, dv = VOFF + (wid & 3) * 1024;
#define RET_GLDS(src, dstoff, imm) __builtin_amdgcn_global_load_lds((const unsigned*)((src) + (imm)), (LAS unsigned*)(lds + (dstoff)), 16, 0, 0)
        __syncthreads();
        for (int i = tid; i < 1728; i += 512) {
            const int o = (i < 768) ? QOFF + i * 16 : (i < 1536) ? KOFF + (i - 768) * 16 : VOFF + (i - 1536) * 16;
            *(LAS u32x4*)(lds + o) = (u32x4){0u, 0u, 0u, 0u};
        }
        {
            const bool q0ok = wid >= 12, q1ok = wid + 8 >= 12, vok = (wid == 3);
            const unsigned char* safe = zrow0 + h * 256 + ((lane & 15) << 4);
            RET_GLDS(q0ok ? pq0 : safe, q0ok ? dq0 : DUMMY, 0); RET_GLDS(q0ok ? pq0 : safe, q0ok ? KOFF + dq0 : DUMMY, 1024);
            RET_GLDS(q1ok ? pq1 : safe, q1ok ? dq1 : DUMMY, 0); RET_GLDS(q1ok ? pq1 : safe, q1ok ? KOFF + dq1 : DUMMY, 1024);
            RET_GLDS(vok ? pv : safe, vok ? dv : DUMMY, 0);
        }
        const size_t CSTEP = (size_t)64 * PB * 2;
#define RET_ISSUE(cc) do { const int bo_ = ((cc) & 3) * RBUF; const bool rl_ = (cc) < 33; const unsigned char* q0_ = pq0 + (size_t)(cc) * CSTEP; const unsigned char* q1_ = pq1 + (size_t)(cc) * CSTEP; const unsigned char* v_ = pv + (size_t)(cc) * CSTEP; \
            RET_GLDS(q0_, rl_ ? bo_ + dq0 : DUMMY, 0); RET_GLDS(q0_, rl_ ? bo_ + KOFF + dq0 : DUMMY, 1024); RET_GLDS(q1_, rl_ ? bo_ + dq1 : DUMMY, 0); RET_GLDS(q1_, rl_ ? bo_ + KOFF + dq1 : DUMMY, 1024); \
            RET_GLDS(v_, (rl_ && wid < 4) ? bo_ + dv : DUMMY, 0); } while (0)
        RET_ISSUE(1); RET_ISSUE(2);
        const int ri = 16 * mt + fr;
        const int oq = QOFF + ri * 256 + ((fq ^ (ri & 3)) << 4) + (((ri >> 2) & 3) << 6);
        const int ok = KOFF + fr * 256 + ((fq ^ (fr & 3)) << 4) + (((fr >> 2) & 3) << 6);
        const int oqp = QOFF + ri * 256 + (((fq >> 1) ^ (ri & 3)) << 4) + (((ri >> 2) & 3) << 6) + 8 * (fq & 1);
        const int rw = 4 * fq + (fr >> 2);
        const int okt = KOFF + rw * 256 + ((((fr >> 1) & 1) ^ (rw & 3)) << 4) + (((rw >> 2) & 3) << 6) + 8 * (fr & 1);
        const int ovt = VOFF + rw * 64 + (16 * nt + 4 * (fr & 3)) * 2;
        f32x4 R[8];
#pragma unroll
        for (int dt = 0; dt < 8; ++dt) R[dt] = Z4;
        for (int c = 0; c < 33; ++c) {
            if (c == 0) asm volatile("s_waitcnt vmcnt(10) lgkmcnt(0)" ::: "memory"); else if (c == 1) asm volatile("s_waitcnt vmcnt(14) lgkmcnt(0)" ::: "memory"); else asm volatile("s_waitcnt vmcnt(18) lgkmcnt(0)" ::: "memory");
            __builtin_amdgcn_s_barrier();
            asm volatile("" ::: "memory");
            RET_ISSUE(c + 3);
            const LAS unsigned char* B0 = lds + (c & 3) * RBUF;
            bf16x8 qn[4];
#pragma unroll
            for (int ks = 0; ks < 4; ++ks) qn[ks] = *(const LAS bf16x8*)(B0 + (oq ^ (ks << 6)));
            f32x4 ST[4];
#pragma unroll
            for (int tj = 0; tj < 4; ++tj) {
                ST[tj] = Z4;
                if (tj <= mt) {
#pragma unroll
                    for (int ks = 0; ks < 4; ++ks) ST[tj] = __builtin_amdgcn_mfma_f32_16x16x32_bf16(*(const LAS bf16x8*)(B0 + ((ok ^ (ks << 6)) + tj * 4096)), qn[ks], ST[tj], 0, 0, 0);
                    if (tj == mt) {
#pragma unroll
                        for (int rg = 0; rg < 4; ++rg) ST[tj][rg] = (fr >= 4 * fq + rg) ? ST[tj][rg] : 0.f;
                    }
                }
            }
            bf16x8 vf[2];
#pragma unroll
            for (int ks2 = 0; ks2 < 2; ++ks2) vf[ks2] = tr8(B0 + ovt + ks2 * 2048, B0 + ovt + ks2 * 2048 + 1024);
            f32x4 ai = __builtin_amdgcn_mfma_f32_16x16x32_bf16(packf(ST[0], ST[1]), vf[0], Z4, 0, 0, 0);
            if (mt >= 2) ai = __builtin_amdgcn_mfma_f32_16x16x32_bf16(packf(ST[2], ST[3]), vf[1], ai, 0, 0, 0);
            f32x4 ac = Z4;
#pragma unroll
            for (int ks = 0; ks < 4; ++ks) {
                const u32x2 a0 = *(const LAS u32x2*)(B0 + (oqp ^ (ks << 6))), a1 = *(const LAS u32x2*)(B0 + (oqp ^ (ks << 6) ^ 32));
                ac = __builtin_amdgcn_mfma_f32_16x16x32_bf16(__builtin_bit_cast(bf16x8, (u32x4){a0.x, a0.y, a1.x, a1.y}), packf(R[2 * ks], R[2 * ks + 1]), ac, 0, 0, 0);
            }
#pragma unroll
            for (int rg = 0; rg < 4; ++rg) {
                const int t = 64 * c - 48 + 16 * mt + 4 * fq + rg;
                bf16_t* dst = (t >= 0) ? Yb + ((size_t)b * L + t) * 512 + h * 128 + dvb * 32 + 16 * nt + fr : sink + tid;
                *dst = (bf16_t)f2bf(ai[rg] + g1 * ac[rg]);
            }
#pragma unroll
            for (int dt = 0; dt < 8; ++dt) {
                f32x4 r = R[dt] * g1;
#pragma unroll
                for (int ks2 = 0; ks2 < 2; ++ks2) {
                    const LAS unsigned char* kp = B0 + ((okt ^ (dt << 5)) + ks2 * 8192);
                    r = __builtin_amdgcn_mfma_f32_16x16x32_bf16(tr8(kp, kp + 4096), vf[ks2], r, 0, 0, 0);
                }
                R[dt] = r * g63;
            }
        }
        VM_WAIT();
#undef RET_ISSUE
#undef RET_GLDS
    }
}

__device__ __forceinline__ void phase_post(const Params& p, int lane, int wid, int G, int bid) {
    unsigned char* ws = p.ws;
    const float* Y = (const float*)(ws + WS_Y); const bf16_t* Yb = (const bf16_t*)(ws + WS_YB); const bf16_t* zB = (const bf16_t*)(ws + WS_ZB);
    const bf16_t* Pv = (const bf16_t*)(ws + WS_CV); const bf16_t* Pg = (const bf16_t*)(ws + WS_G2);
    const float* lnw = p.in[13]; const float* lnb = p.in[14]; const float* gnw = p.in[15];
    bf16_t* mixed = (bf16_t*)(ws + WS_MIXED);
    const bool isA = lane < 32;
    for (int m2 = bid * 8 + wid; m2 < M2; m2 += G * 8) {
        const int b = m2 >> 11, s = m2 & 2047; const size_t m1 = (size_t)b * L + NMETA + s;
        float y[16];
        if (isA) {
            const float* yp = Y + m1 * 512 + lane * 16;
#pragma unroll
            for (int q = 0; q < 4; ++q) { const f32x4 v = *(const f32x4*)(yp + 4 * q); y[4 * q] = v.x; y[4 * q + 1] = v.y; y[4 * q + 2] = v.z; y[4 * q + 3] = v.w; }
        } else {
            const bf16_t* yp = Yb + m1 * 512 + (lane - 32) * 16;
            const u32x4 v0 = *(const u32x4*)yp, v1 = *(const u32x4*)(yp + 8);
#pragma unroll
            for (int q = 0; q < 4; ++q) { y[2 * q] = bflo(v0[q]); y[2 * q + 1] = bfhi(v0[q]); y[8 + 2 * q] = bflo(v1[q]); y[8 + 2 * q + 1] = bfhi(v1[q]); }
        }
        float sm = 0.f;
#pragma unroll
        for (int i = 0; i < 16; ++i) sm += y[i];
        float s4 = sm + __shfl_xor(sm, 1); s4 += __shfl_xor(s4, 2); const float s8 = s4 + __shfl_xor(s4, 4);
        const float mean = isA ? s4 * (1.f / 64.f) : s8 * (1.f / 128.f);
        float sv = 0.f;
#pragma unroll
        for (int i = 0; i < 16; ++i) { y[i] -= mean; sv += y[i] * y[i]; }
        float v4 = sv + __shfl_xor(sv, 1); v4 += __shfl_xor(v4, 2); const float v8 = v4 + __shfl_xor(v4, 4);
        const float rstd = isA ? 1.f / sqrtf(v4 * (1.f / 64.f) + 64e-5f) : 1.f / sqrtf(v8 * (1.f / 128.f) + 1e-5f);
        float o[16];
        if (isA) {
            const int col = lane * 16;
            const u32x4 va = *(const u32x4*)(Pv + m1 * 512 + col), vb = *(const u32x4*)(Pv + m1 * 512 + col + 8);
            const u32x4 ga = *(const u32x4*)(Pg + m1 * 512 + col), gb = *(const u32x4*)(Pg + m1 * 512 + col + 8);
#pragma unroll
            for (int i = 0; i < 16; ++i) {
                const unsigned vw = i < 8 ? va[(i >> 1) & 3] : vb[(i >> 1) & 3], gw = i < 8 ? ga[(i >> 1) & 3] : gb[(i >> 1) & 3];
                const float v = (i & 1) ? bfhi(vw) : bflo(vw), g = (i & 1) ? bfhi(gw) : bflo(gw);
                const int ac = (col & ~63) + 16 * (i >> 2) + 4 * (lane & 3) + (i & 3);
                o[i] = (y[i] * rstd * lnw[ac] + lnb[ac] + v) * g;
            }
        } else {
            const int cb = (lane - 32) * 16;
            const u32x4 ga = *(const u32x4*)(zB + m1 * PB + 1536 + cb), gb = *(const u32x4*)(zB + m1 * PB + 1536 + cb + 8);
#pragma unroll
            for (int i = 0; i < 16; ++i) {
                const unsigned gw = i < 8 ? ga[(i >> 1) & 3] : gb[(i >> 1) & 3];
                const float g = (i & 1) ? bfhi(gw) : bflo(gw);
                o[i] = y[i] * rstd * gnw[cb + i] * (g * sigmoidf_(g));
            }
        }
        bf16_t* op = mixed + (size_t)m2 * 1024 + lane * 16;
        *(u32x4*)op = (u32x4){pk2(o[0], o[1]), pk2(o[2], o[3]), pk2(o[4], o[5]), pk2(o[6], o[7])};
        *(u32x4*)(op + 8) = (u32x4){pk2(o[8], o[9]), pk2(o[10], o[11]), pk2(o[12], o[13]), pk2(o[14], o[15])};
    }
}

struct EpiH2 {
    static constexpr bool PERM = true;
    bf16_t* hmid; const float* x; unsigned char* u8;
    __device__ __forceinline__ void operator()(const f32x4 (&acc)[2][2][4][2], const pg8::DenseOrder::Unit& u, int wr, int wc, int fr, int fq) const {
        const int row0 = u.pm * 256 + wr * 64 + fr, col0 = u.pn * 256 + wc * 32 + 8 * fq;
#pragma unroll
        for (int ai = 0; ai < 2; ++ai)
#pragma unroll
            for (int m = 0; m < 4; ++m) {
                const size_t off = (size_t)(row0 + ai * 128 + m * 16) * D + col0;
#pragma unroll
                for (int bj = 0; bj < 2; ++bj) {
                    const f32x4 v0 = *(const f32x4*)(x + off + bj * 128) + acc[ai][bj][m][0], v1 = *(const f32x4*)(x + off + bj * 128 + 4) + acc[ai][bj][m][1];
                    *(u32x4*)(hmid + off + bj * 128) = (u32x4){pk2(v0[0], v0[1]), pk2(v0[2], v0[3]), pk2(v1[0], v1[1]), pk2(v1[2], v1[3])};
                    *(u32x2*)(u8 + off + bj * 128) = (u32x2){pk4_fp8(v0[0], v0[1], v0[2], v0[3]), pk4_fp8(v1[0], v1[1], v1[2], v1[3])};
                }
            }
    }
};
__device__ __forceinline__ void phase5(const Params& p, LAS unsigned char* lds, int tid, int lane, int wid, int G, int bid) {
    unsigned char* ws = p.ws;
    {
        pg8::DenseOrder S; S.init((const bf16_t*)(ws + WS_MIXED), (const bf16_t*)(ws + WS_WOUT), M2, D, D, G, bid);
        EpiH2 E{(bf16_t*)(ws + WS_HMID), p.in[0], ws + WS_U8};
        pg8::gemm_phase<EpiH2, pg8::DenseOrder, true>(lds, S, E);
    }
}

__device__ __forceinline__ void phase6(const Params& p, LAS unsigned char* lds, int tid, int lane, int wid, int G, int bid) {
    unsigned char* ws = p.ws;
    const bf16_t* hmid = (const bf16_t*)(ws + WS_HMID); const unsigned char* Wr = ws + WS_WR;
    float* rstd2 = (float*)(ws + RT_RSTD2);
    int* asg_e = (int*)(ws + RT_E); float* asg_w = (float*)(ws + RT_W); int* asg_pos = (int*)(ws + RT_POS); int* cntT = (int*)(ws + RT_CNT);
    const float* brg = p.in[19]; const float* bre = p.in[21];
    const int fr = lane & 15, fq = lane >> 4;
    constexpr int WP = 2064, WLO = 36 * WP;
    LAS int* elist = (LAS int*)(lds + 2 * WLO);
    __syncthreads();
    for (int i = tid; i < 2 * 36 * 128; i += 512) {
        const int pl = i / (36 * 128), r = (i / 128) % 36, c = i & 127;
        *(LAS u32x4*)(lds + pl * WLO + r * WP + c * 16) = *(const u32x4*)(Wr + (size_t)pl * 36 * 2048 + r * 2048 + c * 16);
    }
    __syncthreads();
    const f32x4 Z4 = (f32x4){0.f, 0.f, 0.f, 0.f};
    for (int unit = bid; unit < 256; unit += G) {
        const int m2 = unit * 128 + wid * 16 + fr;
        f32x4 acc[3] = {Z4, Z4, Z4};
        float ss = 0.f;
        const bf16_t* hp = hmid + (size_t)m2 * D + 8 * fq;
        int wrow[3];
#pragma unroll
        for (int nt = 0; nt < 3; ++nt) wrow[nt] = min(16 * nt + fr, 35) * WP + 16 * fq;
#pragma unroll 4
        for (int ks = 0; ks < 32; ++ks) {
            const u32x4 hw = *(const u32x4*)(hp + 32 * ks);
#pragma unroll
            for (int q = 0; q < 4; ++q) { const float a = bflo(hw[q]), b = bfhi(hw[q]); ss += a * a + b * b; }
            const bf16x8 hb = __builtin_bit_cast(bf16x8, hw);
#pragma unroll
            for (int nt = 0; nt < 3; ++nt) {
                acc[nt] = __builtin_amdgcn_mfma_f32_16x16x32_bf16(*(const LAS bf16x8*)(lds + wrow[nt] + 64 * ks), hb, acc[nt], 0, 0, 0);
                acc[nt] = __builtin_amdgcn_mfma_f32_16x16x32_bf16(*(const LAS bf16x8*)(lds + WLO + wrow[nt] + 64 * ks), hb, acc[nt], 0, 0, 0);
            }
        }
        ss += __shfl_xor(ss, 16); ss += __shfl_xor(ss, 32);
        const float rs = 1.f / sqrtf(ss * (1.f / D) + 1e-6f);
        if (fq == 0) rstd2[m2] = rs;
        float gl[4];
#pragma unroll
        for (int j = 0; j < 4; ++j) gl[j] = acc[0][j] * rs + brg[j];
        int gi = 0; float gm = gl[0];
#pragma unroll
        for (int j = 1; j < 4; ++j) if (gl[j] > gm) { gm = gl[j]; gi = j; }
        gi = __shfl(gi, fr);
        float el[8];
#pragma unroll
        for (int half = 0; half < 2; ++half) {
            const int q = 1 + 2 * gi + half, snt = q >> 2, src = fr + 16 * (q & 3);
#pragma unroll
            for (int rg = 0; rg < 4; ++rg) {
                const float v0 = __shfl(acc[0][rg], src), v1 = __shfl(acc[1][rg], src), v2 = __shfl(acc[2][rg], src);
                el[4 * half + rg] = (snt == 0) ? v0 : (snt == 1) ? v1 : v2;
            }
        }
        __syncthreads();
        if (fq == 0) {
            float gs = 0.f;
#pragma unroll
            for (int j = 0; j < 4; ++j) gs += expf(gl[j] - gm);
            const float gp = 1.f / gs;
#pragma unroll
            for (int j = 0; j < 8; ++j) el[j] = el[j] * rs + bre[gi * 8 + j];
            int i1 = 0; float e1 = el[0];
#pragma unroll
            for (int j = 1; j < 8; ++j) if (el[j] > e1) { e1 = el[j]; i1 = j; }
            int i2 = -1; float e2 = -3.0e38f;
#pragma unroll
            for (int j = 0; j < 8; ++j) if (j != i1 && el[j] > e2) { e2 = el[j]; i2 = j; }
            const float p2 = expf(e2 - e1), w1 = gp / (1.f + p2), w2 = gp * p2 / (1.f + p2);
            const int a = m2 * 2;
            asg_e[a] = gi * 8 + i1; asg_e[a + 1] = gi * 8 + i2; asg_w[a] = w1; asg_w[a + 1] = w2;
            elist[(wid * 16 + fr) * 2] = gi * 8 + i1; elist[(wid * 16 + fr) * 2 + 1] = gi * 8 + i2;
        }
        __syncthreads();
        if (tid < 256) {
            const int e = elist[tid]; int pos = 0;
            for (int j = 0; j < tid; ++j) pos += (elist[j] == e) ? 1 : 0;
            asg_pos[unit * 256 + tid] = pos;
        }
        if (tid < 32) {
            int c = 0;
            for (int j = 0; j < 256; ++j) c += (elist[j] == tid) ? 1 : 0;
            cntT[unit * 32 + tid] = c;
        }
    }
}

__device__ __forceinline__ void phase7(const Params& p, LAS unsigned char* lds, int tid, int G, int bid) {
    unsigned char* ws = p.ws;
    const int* asg_e = (const int*)(ws + RT_E); const int* asg_pos = (const int*)(ws + RT_POS); const int* cntT = (const int*)(ws + RT_CNT);
    int* row_asg = (int*)(ws + RT_ROW); int* gtot = (int*)(ws + RT_TOT);
    float* row_w = (float*)(ws + RT_ROWW); float* row_rs = (float*)(ws + RT_ROWRS); const float* asg_w = (const float*)(ws + RT_W); const float* rstd2 = (const float*)(ws + RT_RSTD2);
    LAS int* tot = (LAS int*)lds; LAS int* base = tot + 32; LAS int* pst = tot + 64; LAS int* ptot = tot + 128; LAS int* pbase = tot + 128 + 512;
    for (int unit = bid; unit < 256; unit += G) {
        __syncthreads();
        {
            const int e = tid & 31, part = tid >> 5; int t = 0, bs = 0;
#pragma unroll 4
            for (int w = 16 * part; w < 16 * part + 16; ++w) { const int c = cntT[w * 32 + e]; bs += (w < unit) ? c : 0; t += c; }
            ptot[tid] = t; pbase[tid] = bs;
        }
        __syncthreads();
        if (tid < 32) {
            int t = 0, bs = 0;
#pragma unroll
            for (int q = 0; q < 16; ++q) { t += ptot[q * 32 + tid]; bs += pbase[q * 32 + tid]; }
            tot[tid] = t; base[tid] = bs;
        }
        __syncthreads();
        if (tid == 0) { int ps = 0; for (int e = 0; e < 32; ++e) { pst[e] = ps; ps += (tot[e] + 255) & ~255; } }
        __syncthreads();
        if (unit == 0 && tid < 32) { gtot[tid] = tot[tid]; gtot[32 + tid] = pst[tid]; }
        if (tid < 256) {
            const int a = unit * 256 + tid, e = asg_e[a];
            const int row = pst[e] + base[e] + asg_pos[a];
            row_asg[row] = a; row_w[row] = asg_w[a] * (1.f / 32.f); row_rs[row] = rstd2[a >> 1] * (1.f / 32.f);
        }
    }
}

template <bool GATHER_>
struct MoeOrder {
    static constexpr bool GATHER = GATHER_, FP8 = true;
    struct Unit { int e, rt, pn, nvalid, rowbase; };
    const unsigned char* A; const unsigned char* W; int K; size_t wstride; const int* row_asg; const LAS int* ltot; const LAS int* lpst; const LAS int* lcum; int NU, G, c;
    __device__ __forceinline__ bool next(int i, Unit& u) const {
        const int Lx = i * G + c; if (Lx >= NU) return false;
        int e = 0;
        for (int j = 1; j < 32; ++j) e = (Lx >= lcum[j]) ? j : e;
        e = __builtin_amdgcn_readfirstlane(e);
        const int ul = Lx - __builtin_amdgcn_readfirstlane(lcum[e]);
        u.e = e; u.rt = ul >> 2; u.pn = ul & 3; u.rowbase = __builtin_amdgcn_readfirstlane(lpst[e]) + u.rt * 256; u.nvalid = min(256, __builtin_amdgcn_readfirstlane(ltot[e]) - u.rt * 256);
        return true;
    }
    __device__ __forceinline__ const char* a_base(const Unit& u) const { return GATHER ? (const char*)A : (const char*)A + (size_t)u.rowbase * K; }
    __device__ __forceinline__ const char* b_base(const Unit& u) const { return (const char*)W + (size_t)u.e * wstride + (size_t)u.pn * 256 * K; }
    __device__ __forceinline__ void a_tok(const Unit& u, int tid, unsigned& w0, unsigned& w1) const {
        w0 = 0u; w1 = 0u;
        if (GATHER) {
            const int* rows = row_asg + u.rowbase;
#pragma unroll
            for (int i = 0; i < 2; ++i) {
                int R, C; pg8::stage_rc(tid * 16 + i * 8192, R, C);
                const unsigned a0 = (unsigned)rows[(R < u.nvalid) ? R : 0] >> 1, a1 = (unsigned)rows[(R + 128 < u.nvalid) ? R + 128 : 0] >> 1;
                w0 |= a0 << (16 * i); w1 |= a1 << (16 * i);
            }
        }
    }
};
struct EpiGU2 {
    static constexpr bool PERM = true;
    unsigned char* hid; const float* row_rs;
    __device__ __forceinline__ void operator()(const f32x4 (&acc)[2][2][4][2], const MoeOrder<true>::Unit& u, int wr, int wc, int fr, int fq) const {
        float rsv[2][4];
#pragma unroll
        for (int ai = 0; ai < 2; ++ai)
#pragma unroll
            for (int m = 0; m < 4; ++m) { const int r = ai * 128 + wr * 64 + m * 16 + fr; rsv[ai][m] = row_rs[u.rowbase + min(r, u.nvalid - 1)]; }
#pragma unroll
        for (int ai = 0; ai < 2; ++ai)
#pragma unroll
            for (int m = 0; m < 4; ++m) {
                const int r = ai * 128 + wr * 64 + m * 16 + fr;
                const float rs = rsv[ai][m];
                float o[8];
#pragma unroll
                for (int n = 0; n < 2; ++n)
#pragma unroll
                    for (int j = 0; j < 4; ++j) { const float g = acc[ai][0][m][n][j] * rs, up = acc[ai][1][m][n][j] * rs; o[n * 4 + j] = g * sigmoidf_(g) * up; }
                if (r < u.nvalid) *(u32x2*)(hid + (size_t)(u.rowbase + r) * DE + u.pn * 128 + wc * 32 + 8 * fq) = (u32x2){pk4_fp8(o[0], o[1], o[2], o[3]), pk4_fp8(o[4], o[5], o[6], o[7])};
            }
    }
};
struct EpiDown2 {
    static constexpr bool PERM = true;
    unsigned char* ym0; const int* row_asg; const float* row_w;
    __device__ __forceinline__ void operator()(const f32x4 (&acc)[2][2][4][2], const MoeOrder<false>::Unit& u, int wr, int wc, int fr, int fq) const {
        int av[2][4]; float wv[2][4];
#pragma unroll
        for (int ai = 0; ai < 2; ++ai)
#pragma unroll
            for (int m = 0; m < 4; ++m) { const int rc = u.rowbase + min(ai * 128 + wr * 64 + m * 16 + fr, u.nvalid - 1); av[ai][m] = row_asg[rc]; wv[ai][m] = row_w[rc]; }
#pragma unroll
        for (int ai = 0; ai < 2; ++ai)
#pragma unroll
            for (int m = 0; m < 4; ++m) {
                const int r = ai * 128 + wr * 64 + m * 16 + fr;
                const int a = av[ai][m]; const float w = wv[ai][m];
                unsigned char* dst = ym0 + (size_t)(a & 1) * (WS_YM1 - WS_YM0) + (size_t)(a >> 1) * D + u.pn * 256 + wc * 32 + 8 * fq;
                if (r < u.nvalid) {
#pragma unroll
                    for (int bj = 0; bj < 2; ++bj) {
                        const f32x4 v0 = acc[ai][bj][m][0] * w, v1 = acc[ai][bj][m][1] * w;
                        *(u32x2*)(dst + bj * 128) = (u32x2){pk4_fp8(v0[0], v0[1], v0[2], v0[3]), pk4_fp8(v1[0], v1[1], v1[2], v1[3])};
                    }
                }
            }
    }
};
template <int WHICH>
__device__ __forceinline__ void phase_moe(const Params& p, LAS unsigned char* lds, int tid, int G, int bid) {
    unsigned char* ws = p.ws;
    const int* gtot = (const int*)(ws + RT_TOT); const int* row_asg = (const int*)(ws + RT_ROW);
    LAS int* ltot = (LAS int*)(lds + 131072); LAS int* lpst = ltot + 32; LAS int* lcum = ltot + 64;
    __syncthreads();
    if (tid < 32) { ltot[tid] = gtot[tid]; lpst[tid] = gtot[32 + tid]; }
    __syncthreads();
    if (tid == 0) { int c = 0; for (int e = 0; e < 32; ++e) { lcum[e] = c; c += ((ltot[e] + 255) >> 8) * 4; } lcum[32] = c; }
    __syncthreads();
    const int NU = __builtin_amdgcn_readfirstlane(lcum[32]);
    if (WHICH == 0) {
        MoeOrder<true> S{(const unsigned char*)(ws + WS_U8), (const unsigned char*)p.out, D, (size_t)1024 * 1024, row_asg, ltot, lpst, lcum, NU, G, bid};
        EpiGU2 E{(unsigned char*)(ws + WS_HID), (const float*)(ws + RT_ROWRS)};
        pg8::gemm_phase<EpiGU2, MoeOrder<true>, true>(lds, S, E);
    } else {
        MoeOrder<false> S{(const unsigned char*)(ws + WS_HID), (const unsigned char*)p.out + (size_t)NE * 1024 * 1024, DE, (size_t)1024 * 512, row_asg, ltot, lpst, lcum, NU, G, bid};
        EpiDown2 E{ws + WS_YM0, row_asg, (const float*)(ws + RT_ROWW)};
        pg8::gemm_phase<EpiDown2, MoeOrder<false>, true>(lds, S, E);
    }
}

__device__ __forceinline__ void phase_final(const Params& p, int lane, int wid, int G, int bid) {
    unsigned char* ws = p.ws;
    const bf16_t* hmid = (const bf16_t*)(ws + WS_HMID); const unsigned char* y0 = ws + WS_YM0; const unsigned char* y1 = ws + WS_YM1;
    const float* gfin = p.in[25]; float* out = p.out;
    for (int m2 = bid * 8 + wid; m2 < M2; m2 += G * 8) {
        f32x4 v[4]; float s = 0.f;
#pragma unroll
        for (int j = 0; j < 4; ++j) {
            const size_t o = (size_t)m2 * D + 4 * lane + 256 * j;
            const u32x2 hw = *(const u32x2*)(hmid + o); f32x4 hv = (f32x4){bflo(hw.x), bfhi(hw.x), bflo(hw.y), bfhi(hw.y)};
            const unsigned a = *(const unsigned*)(y0 + o), b = *(const unsigned*)(y1 + o);
            hv.x += __builtin_amdgcn_cvt_f32_fp8(a, 0) + __builtin_amdgcn_cvt_f32_fp8(b, 0); hv.y += __builtin_amdgcn_cvt_f32_fp8(a, 1) + __builtin_amdgcn_cvt_f32_fp8(b, 1);
            hv.z += __builtin_amdgcn_cvt_f32_fp8(a, 2) + __builtin_amdgcn_cvt_f32_fp8(b, 2); hv.w += __builtin_amdgcn_cvt_f32_fp8(a, 3) + __builtin_amdgcn_cvt_f32_fp8(b, 3);
            v[j] = hv; s += (hv.x * hv.x + hv.y * hv.y) + (hv.z * hv.z + hv.w * hv.w);
        }
        s = wave_sum(s);
        const float rs = 1.f / sqrtf(s * (1.f / D) + 1e-6f);
#pragma unroll
        for (int j = 0; j < 4; ++j) {
            const f32x4 g = *(const f32x4*)(gfin + 4 * lane + 256 * j);
            *(f32x4*)(out + (size_t)m2 * D + 4 * lane + 256 * j) = v[j] * rs * g;
        }
    }
}

__global__ void __launch_bounds__(512, 2) fwd(Params p) {
    extern __shared__ __attribute__((aligned(16))) unsigned char lds_raw[];
    LAS unsigned char* lds = (LAS unsigned char*)lds_raw;
    const int G = gridDim.x, bid = blockIdx.x;
    volatile LAS unsigned* xbw = (volatile LAS unsigned*)(lds + LDS_XB);
    if (threadIdx.x < 4) xbw[threadIdx.x] = 0u;
    __syncthreads();
    const int lo = p.ph_lo, hi = p.ph_hi;
    unsigned* barw = (unsigned*)(p.ws + WS_CTL) + CW_BAR;
    XcdBarrier bar; bar.bar = barw; bar.x = 0; bar.st = xbw;
    if (hi - lo > 1) bar = xcd_barrier_post(barw, xbw);
#define IN(k) (lo <= (k) && (k) < hi)
#define SEAM(k) do { if (IN(k) && IN((k) + 1)) xcd_barrier(bar); } while (0)
#define REP(k) int nrep_##k = ((PROBE_REP == (k)) ? 2 : 1); if (PROBE_REP == (k)) asm volatile("" : "+s"(nrep_##k)); for (int rep_ = 0; rep_ < nrep_##k; ++rep_)
#define FRESH() int tid = threadIdx.x; asm volatile("" : "+v"(tid)); const int lane = tid & 63, wid = __builtin_amdgcn_readfirstlane(tid >> 6); (void)lane; (void)wid;
    if (IN(0)) { FRESH(); REP(0) { phase0(p, lds, tid, lane, wid, G, bid); __syncthreads(); } } SEAM(0);
    if (IN(1)) { FRESH(); REP(1) phase1(p, lds, tid, G, bid); if (bid >= G - 8) {
            if (tid == 0) { unsigned* mz = (unsigned*)(p.ws + WS_CTL) + CW_MZ; XB_SPIN(xb_ld(mz) < (unsigned)MZ_READY, barw); __builtin_amdgcn_fence(__ATOMIC_ACQUIRE, "agent"); }
            phase_rwkv_pre<true>(p, lds, tid, lane, wid, G, bid); } } SEAM(1);
    if (IN(2)) { FRESH(); REP(2) phase_rwkv_pre<false>(p, lds, tid, lane, wid, G, bid); } SEAM(2);
    if (IN(3)) { FRESH(); REP(30) phase_rwkv_seq(p, lds, lane, wid, G, bid); REP(31) phase_ret(p, lds, tid, lane, wid, G, bid); } SEAM(3);
    if (IN(4)) { FRESH(); REP(4) phase_post(p, lane, wid, G, bid); } SEAM(4);
    if (IN(5)) { FRESH(); REP(5) { phase5(p, lds, tid, lane, wid, G, bid); __syncthreads(); } } SEAM(5);
    if (IN(6)) { FRESH(); REP(6) phase6(p, lds, tid, lane, wid, G, bid); } SEAM(6);
    if (IN(7)) { FRESH(); REP(7) phase7(p, lds, tid, G, bid); } SEAM(7);
    if (IN(8)) { FRESH(); REP(8) phase_moe<0>(p, lds, tid, G, bid); } SEAM(8);
    if (IN(9)) { FRESH(); REP(9) phase_moe<1>(p, lds, tid, G, bid); } SEAM(9);
    if (IN(10)) { FRESH(); REP(10) phase_final(p, lane, wid, G, bid); }
#undef FRESH
#undef REP
#undef IN
#undef SEAM
}

#ifndef N_LAUNCH_MODE
#define N_LAUNCH_MODE 1
#endif
extern "C" void kernel_launch(void* const* d_in, const int* in_sizes, int n_in, void* d_out, int out_size, void* d_ws, size_t ws_size, hipStream_t stream) {
    static int grid = 0;
    if (grid == 0) {
        if (n_in != 26 || out_size != M2 * D || ws_size < WS_END) { fprintf(stderr, "kernel_launch: unexpected shapes (n_in %d out %d ws %zu)\n", n_in, out_size, ws_size); grid = -1; return; }
        int dev = 0, cus = 0;
        if (hipGetDevice(&dev) != hipSuccess || hipDeviceGetAttribute(&cus, hipDeviceAttributeMultiprocessorCount, dev) != hipSuccess) { grid = -1; return; }
        if (hipFuncSetAttribute((const void*)fwd, hipFuncAttributeMaxDynamicSharedMemorySize, LDS_BYTES) != hipSuccess) { grid = -1; return; }
        grid = cus;
    }
    if (grid < 0) return;
    (void)hipMemsetAsync((char*)d_ws + WS_CTL, 0, CTL_ZERO_BYTES, stream);
    Params a{};
    for (int i = 0; i < 26; ++i) a.in[i] = (const float*)d_in[i];
    a.out = (float*)d_out; a.ws = (unsigned char*)d_ws;
#if N_LAUNCH_MODE == 1
    a.ph_lo = 0; a.ph_hi = NPHASE;
    hipLaunchKernelGGL(fwd, dim3(grid), dim3(512), LDS_BYTES, stream, a);
#else
    for (int ph = 0; ph < NPHASE; ++ph) { a.ph_lo = ph; a.ph_hi = ph + 1; hipLaunchKernelGGL(fwd, dim3(grid), dim3(512), LDS_BYTES, stream, a); }
#endif
}
```
